# Optimizing an MI355X kernel written in HIP

```python
import math
import jax, jax.numpy as jnp
from jax import lax
import numpy as np

D_MODEL = 1024
BATCH = 2
SEQ = 16384
DEPTH = 1
DEC_BATCH = 4
DEC_SEQ = 4096
PAST_LEN = 128

HEAD_DIM = 64
N_GQA_HEADS = 8
N_GQA_KV = 2
GQA_GROUP = N_GQA_HEADS // N_GQA_KV
N_DIFF_HEADS = 4
DIFF_V_DIM = 2 * HEAD_DIM
GQA_WIDTH = N_GQA_HEADS * HEAD_DIM
DIFF_WIDTH = N_DIFF_HEADS * DIFF_V_DIM
MIX_WIDTH = GQA_WIDTH + DIFF_WIDTH
GQA_Q_COLS = N_GQA_HEADS * HEAD_DIM
GQA_KV_COLS = N_GQA_KV * HEAD_DIM
DIFF_QK_COLS = N_DIFF_HEADS * 2 * HEAD_DIM
DIFF_V_COLS = N_DIFF_HEADS * DIFF_V_DIM
IN_WIDTH = GQA_Q_COLS + 2 * GQA_KV_COLS + 2 * DIFF_QK_COLS + DIFF_V_COLS
D_FF = -(-8 * D_MODEL // (3 * 256)) * 256
GRID_W = 64
Q_BLOCK = 128
NUM_BUCKETS = 32
MAX_DISTANCE = 128
ROPE_THETA = 10000.0
EPS = 1e-6
ATTN_SCALE = 1.0 / math.sqrt(HEAD_DIM)

kernel_name = 'hybrid_gqa_axialrope_diffattn_encoder'


def rmsnorm(x, g):
    xf = x.astype(jnp.float32)
    y = xf * lax.rsqrt(jnp.mean(xf * xf, axis=-1, keepdims=True) + EPS)
    return (y * g.astype(jnp.float32)).astype(x.dtype)


def axial_rope_tables(n):
    rows = n // GRID_W
    row = jnp.repeat(jnp.arange(rows), GRID_W).astype(jnp.float32)
    col = jnp.tile(jnp.arange(GRID_W), rows).astype(jnp.float32)
    half = HEAD_DIM // 2
    inv = ROPE_THETA ** (-jnp.arange(0, half, 2, dtype=jnp.float32) / half)
    ang_r = row[:, None] * inv[None, :]
    ang_c = col[:, None] * inv[None, :]
    ang = jnp.concatenate([ang_r, ang_r, ang_c, ang_c], axis=-1)
    return jnp.cos(ang), jnp.sin(ang)


def apply_rope(x, cos, sin):
    xf = x.astype(jnp.float32)
    xs = xf.reshape(*xf.shape[:-1], 2, 2, HEAD_DIM // 4)
    rot = jnp.stack([-xs[..., 1, :], xs[..., 0, :]], axis=-2).reshape(xf.shape)
    bshape = (1, cos.shape[0]) + (1,) * (x.ndim - 3) + (HEAD_DIM,)
    return (xf * cos.reshape(bshape) + rot * sin.reshape(bshape)).astype(x.dtype)


def rel_bucket(rel):
    half = NUM_BUCKETS // 2
    max_exact = half // 2
    n = jnp.abs(rel)
    nf = jnp.maximum(n, max_exact).astype(jnp.float32)
    large = max_exact + (jnp.log(nf / max_exact) / math.log(MAX_DISTANCE / max_exact)
                         * (half - max_exact)).astype(jnp.int32)
    large = jnp.minimum(large, half - 1)
    return jnp.where(rel > 0, half, 0) + jnp.where(n < max_exact, n, large)


def gqa_attention(q, k, v):
    b, n = q.shape[0], q.shape[1]
    nblk = n // Q_BLOCK
    qb = jnp.moveaxis(q.reshape(b, nblk, Q_BLOCK, *q.shape[2:]), 1, 0)

    def one(qblk):
        s = jnp.einsum('bqkgd,bskd->bkgqs', qblk, k, preferred_element_type=jnp.float32) * ATTN_SCALE
        p = jax.nn.softmax(s, axis=-1).astype(v.dtype)
        return jnp.einsum('bkgqs,bskd->bqkgd', p, v)

    out = lax.map(one, qb)
    return jnp.moveaxis(out, 0, 1).reshape(b, n, GQA_WIDTH)


def diff_attention(q, k, v, lam, rel_bias):
    b, n = q.shape[0], q.shape[1]
    nblk = n // Q_BLOCK
    qb = jnp.moveaxis(q.reshape(b, nblk, Q_BLOCK, *q.shape[2:]), 1, 0)
    starts = jnp.arange(nblk) * Q_BLOCK
    kpos = jnp.arange(n)

    def one(args):
        qblk, start = args
        qpos = start + jnp.arange(Q_BLOCK)
        bucket = rel_bucket(kpos[None, :] - qpos[:, None])
        bias = jnp.moveaxis(rel_bias[bucket], -1, 0).astype(jnp.float32)
        s = jnp.einsum('bqhjd,bshjd->bhjqs', qblk, k, preferred_element_type=jnp.float32) * ATTN_SCALE
        p = jax.nn.softmax(s + bias[None, :, None], axis=-1)
        a = p[:, :, 0] - lam * p[:, :, 1]
        return jnp.einsum('bhqs,bshe->bqhe', a.astype(v.dtype), v)

    out = lax.map(one, (qb, starts))
    return jnp.moveaxis(out, 0, 1).reshape(b, n, N_DIFF_HEADS, DIFF_V_DIM)


def encoder_layer(x, c, layer_idx, rel_bias, w_ada, b_ada, g_pre_mix, w_in, g_q, g_k,
                  lam_q1, lam_k1, lam_q2, lam_k2, g_subln, w_out, g_post_mix,
                  g_pre_ffn, w_gu, w_down, g_post_ffn):
    b, n, _ = x.shape
    mod = jax.nn.silu(c) @ w_ada + b_ada
    sh1, sc1, gt1, sh2, sc2, gt2 = jnp.split(mod[:, None, :], 6, axis=-1)

    h = rmsnorm(x, g_pre_mix) * (1 + sc1) + sh1
    proj = h @ w_in
    o1 = GQA_Q_COLS
    o2 = o1 + GQA_KV_COLS
    o3 = o2 + GQA_KV_COLS
    o4 = o3 + DIFF_QK_COLS
    o5 = o4 + DIFF_QK_COLS
    qa = proj[..., :o1].reshape(b, n, N_GQA_KV, GQA_GROUP, HEAD_DIM)
    ka = proj[..., o1:o2].reshape(b, n, N_GQA_KV, HEAD_DIM)
    va = proj[..., o2:o3].reshape(b, n, N_GQA_KV, HEAD_DIM)
    qd = proj[..., o3:o4].reshape(b, n, N_DIFF_HEADS, 2, HEAD_DIM)
    kd = proj[..., o4:o5].reshape(b, n, N_DIFF_HEADS, 2, HEAD_DIM)
    vd = proj[..., o5:].reshape(b, n, N_DIFF_HEADS, DIFF_V_DIM)

    cos, sin = axial_rope_tables(n)
    qa = apply_rope(rmsnorm(qa, g_q), cos, sin)
    ka = apply_rope(rmsnorm(ka, g_k), cos, sin)
    out_a = gqa_attention(qa, ka, va)

    lam_init = 0.8 - 0.6 * math.exp(-0.3 * layer_idx)
    lam = (jnp.exp(jnp.sum(lam_q1.astype(jnp.float32) * lam_k1.astype(jnp.float32)))
           - jnp.exp(jnp.sum(lam_q2.astype(jnp.float32) * lam_k2.astype(jnp.float32))) + lam_init)
    out_d = diff_attention(qd, kd, vd, lam, rel_bias)
    out_d = (rmsnorm(out_d, g_subln) * (1.0 - lam_init)).reshape(b, n, DIFF_WIDTH)

    mix = jnp.concatenate([out_a, out_d], axis=-1) @ w_out
    x = x + gt1 * rmsnorm(mix, g_post_mix)

    h = rmsnorm(x, g_pre_ffn) * (1 + sc2) + sh2
    gate, up = jnp.split(h @ w_gu, 2, axis=-1)
    f = (jax.nn.silu(gate) * up) @ w_down
    return x + gt2 * rmsnorm(f, g_post_ffn)


def trunk(x, c, rel_bias, w_ada, b_ada, g_pre_mix, w_in, g_q, g_k, lam_q1, lam_k1,
          lam_q2, lam_k2, g_subln, w_out, g_post_mix, g_pre_ffn, w_gu, w_down, g_post_ffn):
    for l in range(DEPTH):
        x = encoder_layer(x, c, l, rel_bias, w_ada[l], b_ada[l], g_pre_mix[l], w_in[l],
                          g_q[l], g_k[l], lam_q1[l], lam_k1[l], lam_q2[l], lam_k2[l],
                          g_subln[l], w_out[l], g_post_mix[l], g_pre_ffn[l], w_gu[l],
                          w_down[l], g_post_ffn[l])
    return x


def setup_inputs(seed: int = 0) -> dict:
    key = jax.random.key(seed)
    ks = jax.random.split(key, 24)
    f32 = jnp.float32

    def nrm(k, shape, scale):
        return jax.random.normal(k, shape, f32) * scale

    def gain(k, shape):
        return 1.0 + 0.05 * jax.random.normal(k, shape, f32)

    return {
        'x_prompt': nrm(ks[0], (BATCH, SEQ, D_MODEL), 1.0),
        'x_sample': nrm(ks[1], (DEC_BATCH, DEC_SEQ, D_MODEL), 1.0),
        'c_prompt': nrm(ks[2], (BATCH, D_MODEL), 1.0),
        'c_sample': nrm(ks[3], (DEC_BATCH, D_MODEL), 1.0),
        'rel_bias': nrm(ks[4], (NUM_BUCKETS, N_DIFF_HEADS), 0.5),
        'w_ada': nrm(ks[5], (DEPTH, D_MODEL, 6 * D_MODEL), 0.5 * D_MODEL ** -0.5),
        'b_ada': nrm(ks[6], (DEPTH, 6 * D_MODEL), 0.01),
        'g_pre_mix': gain(ks[7], (DEPTH, D_MODEL)),
        'w_in': nrm(ks[8], (DEPTH, D_MODEL, IN_WIDTH), D_MODEL ** -0.5),
        'g_q': gain(ks[9], (DEPTH, HEAD_DIM)),
        'g_k': gain(ks[10], (DEPTH, HEAD_DIM)),
        'lam_q1': nrm(ks[11], (DEPTH, HEAD_DIM), 0.1),
        'lam_k1': nrm(ks[12], (DEPTH, HEAD_DIM), 0.1),
        'lam_q2': nrm(ks[13], (DEPTH, HEAD_DIM), 0.1),
        'lam_k2': nrm(ks[14], (DEPTH, HEAD_DIM), 0.1),
        'g_subln': gain(ks[15], (DEPTH, DIFF_V_DIM)),
        'w_out': nrm(ks[16], (DEPTH, MIX_WIDTH, D_MODEL), MIX_WIDTH ** -0.5),
        'g_post_mix': gain(ks[17], (DEPTH, D_MODEL)),
        'g_pre_ffn': gain(ks[18], (DEPTH, D_MODEL)),
        'w_gu': nrm(ks[19], (DEPTH, D_MODEL, 2 * D_FF), D_MODEL ** -0.5),
        'w_down': nrm(ks[20], (DEPTH, D_FF, D_MODEL), D_FF ** -0.5),
        'g_post_ffn': gain(ks[21], (DEPTH, D_MODEL)),
    }


def reference(x_prompt, x_sample, c_prompt, c_sample, rel_bias, w_ada, b_ada, g_pre_mix,
              w_in, g_q, g_k, lam_q1, lam_k1, lam_q2, lam_k2, g_subln, w_out, g_post_mix,
              g_pre_ffn, w_gu, w_down, g_post_ffn):
    y_prompt = trunk(x_prompt, c_prompt, rel_bias, w_ada, b_ada, g_pre_mix, w_in, g_q, g_k,
                     lam_q1, lam_k1, lam_q2, lam_k2, g_subln, w_out, g_post_mix,
                     g_pre_ffn, w_gu, w_down, g_post_ffn)
    y_sample = trunk(x_sample, c_sample, rel_bias, w_ada, b_ada, g_pre_mix, w_in, g_q, g_k,
                     lam_q1, lam_k1, lam_q2, lam_k2, g_subln, w_out, g_post_mix,
                     g_pre_ffn, w_gu, w_down, g_post_ffn)
    return (y_prompt, y_sample)
```

```cpp
#include <hip/hip_runtime.h>
#include <hip/hip_cooperative_groups.h>
#include <cstdio>
#include <cstdint>
namespace cg = cooperative_groups;

namespace pg8 {
#define PG8_LAS __attribute__((address_space(3)))
typedef unsigned short bf16_t;
typedef short bf16x8 __attribute__((ext_vector_type(8)));
typedef float f32x4 __attribute__((ext_vector_type(4)));
typedef unsigned u32x4 __attribute__((ext_vector_type(4)));
constexpr int BM = 256, BK = 64, HALF = 128, HTB = HALF * BK * 2, STAGE_BYTES = 8 * HTB, NXCD = 8, WGM = 8;

__host__ __device__ __forceinline__ int lds_byte(int r, int c) { const int st = (r >> 4) * 2 + (c >> 5), rr = r & 15, cc = c & 31, ob = rr * 64 + cc * 2; return st * 1024 + (ob ^ (((ob >> 9) & 1) << 5)); }
__host__ __device__ __forceinline__ void stage_rc(int b, int& R, int& C) { const int st = b / 1024, sb = b % 1024, swz = sb ^ (((sb >> 9) & 1) << 5); R = (st >> 1) * 16 + swz / 64; C = (st & 1) * 32 + (swz % 64) / 2; }
__host__ __device__ __forceinline__ int perm32(int rho) { const int n = rho >> 4, i = rho & 15; return 8 * (i >> 2) + 4 * n + (i & 3); }

struct Unit { int pm, pn; };
struct Gemm { const bf16_t* A; const bf16_t* Bt; int M, N, K; };

struct StaticOrder {
    int nM, nN, nwg, G, c;
    __host__ __device__ void init(int M, int N, int G_, int c_) { nM = M / BM; nN = N / BM; nwg = nM * nN; G = G_; c = c_; }
    __host__ __device__ bool next(int i, Unit& u) const {
        const long L = (long)i * G + c; if (L >= nwg) return false;
        int wgid = (int)L; { const int q = nwg / NXCD, r = nwg % NXCD, xcd = wgid % NXCD, off = wgid / NXCD; wgid = (xcd < r ? xcd * (q + 1) : r * (q + 1) + (xcd - r) * q) + off; }
        const int nig = WGM * nN, gid = wgid / nig, fm = gid * WGM, gsz = (nM - fm) < WGM ? (nM - fm) : WGM;
        u.pm = fm + ((wgid % nig) % gsz); u.pn = (wgid % nig) / gsz; return true;
    }
    __device__ __forceinline__ void a_ready(const Unit&) const {}
    __device__ __forceinline__ void done(const Unit&) const {}
};

__device__ __forceinline__ unsigned cvt_pk_bf16(float lo, float hi) { unsigned r; asm volatile("v_cvt_pk_bf16_f32 %0, %1, %2" : "=v"(r) : "v"(lo), "v"(hi)); return r; }

struct EpiBf16 {
    static constexpr bool PERM = true, AFTER_DRAIN = false;
    bf16_t* O; int ldc;
    __device__ __forceinline__ void operator()(const f32x4 (&acc)[2][2][4][2], const Unit& u, int wr, int wc, int fr, int fq) const {
        const int row0 = u.pm * BM + wr * 64 + fr; const int col0 = u.pn * BM + wc * 32 + 8 * fq;
#pragma unroll
        for (int ai = 0; ai < 2; ++ai)
#pragma unroll
            for (int m = 0; m < 4; ++m) { bf16_t* rowp = O + (size_t)(row0 + ai * HALF + m * 16) * ldc + col0;
#pragma unroll
                for (int bj = 0; bj < 2; ++bj) { const f32x4 v0 = acc[ai][bj][m][0], v1 = acc[ai][bj][m][1];
                    u32x4 w; w.x = cvt_pk_bf16(v0[0], v0[1]); w.y = cvt_pk_bf16(v0[2], v0[3]); w.z = cvt_pk_bf16(v1[0], v1[1]); w.w = cvt_pk_bf16(v1[2], v1[3]);
                    *(u32x4*)(rowp + bj * HALF) = w; } }
    }
};
__device__ __forceinline__ float silu_mul(float g, float u) { const float e = __builtin_amdgcn_exp2f(-1.4426950408889634f * g); return g * __builtin_amdgcn_rcpf(1.0f + e) * u; }
struct EpiSwiGLU {
    static constexpr bool PERM = true, AFTER_DRAIN = false;
    bf16_t* O; int ldc;
    __device__ __forceinline__ void operator()(const f32x4 (&acc)[2][2][4][2], const Unit& u, int wr, int wc, int fr, int fq) const {
        const int row0 = u.pm * BM + wr * 64 + fr; const int col0 = u.pn * HALF + wc * 32 + 8 * fq;
#pragma unroll
        for (int ai = 0; ai < 2; ++ai)
#pragma unroll
            for (int m = 0; m < 4; ++m) { bf16_t* rowp = O + (size_t)(row0 + ai * HALF + m * 16) * ldc + col0;
                const f32x4 g0 = acc[ai][0][m][0], g1 = acc[ai][0][m][1], u0 = acc[ai][1][m][0], u1 = acc[ai][1][m][1];
                u32x4 w; w.x = cvt_pk_bf16(silu_mul(g0[0], u0[0]), silu_mul(g0[1], u0[1])); w.y = cvt_pk_bf16(silu_mul(g0[2], u0[2]), silu_mul(g0[3], u0[3]));
                w.z = cvt_pk_bf16(silu_mul(g1[0], u1[0]), silu_mul(g1[1], u1[1])); w.w = cvt_pk_bf16(silu_mul(g1[2], u1[2]), silu_mul(g1[3], u1[3]));
                *(u32x4*)rowp = w; }
    }
};

template <class Epi, class Sched, bool ALIGN_EPI = false, bool SP2 = false>
__device__ __forceinline__ void gemm_phase(PG8_LAS unsigned char* lds, const Gemm g, const Sched& S, const Epi& E) {
    int tid_ = threadIdx.x; asm volatile("" : "+v"(tid_));
    const int tid = tid_, wid = __builtin_amdgcn_readfirstlane(tid >> 6), lane = tid & 63, wr = wid >> 2, wc = wid & 3, fr = lane & 15, fq = lane >> 4;
    const int K = g.K, nt = K / BK;
    unsigned voffA[2], voffB[2];
#pragma unroll
    for (int i = 0; i < 2; ++i) { int R, C; stage_rc(tid * 16 + i * 8192, R, C); const int Rb = Epi::PERM ? ((R & ~31) + perm32(R & 31)) : R;
        voffA[i] = (unsigned)(R * K + C) * 2u; voffB[i] = (unsigned)(Rb * K + C) * 2u; }
    const size_t kstep = (size_t)(BK * 2);
    const size_t hstep = (size_t)HALF * K * 2;
    const size_t tstep = 2 * hstep;
    const unsigned ldsw = (unsigned)wid * 1024u;
    const int aoff = lds_byte(wr * 64 + fr, fq * 8), boff = lds_byte(wc * 32 + fr, fq * 8);
#define PG8_SA(b, h) (((b) * 2 + (h)) * HTB)
#define PG8_SB(b, h) ((4 + (b) * 2 + (h)) * HTB)
#define PG8_STAGE(bufoff, gbase, voff) do { _Pragma("unroll") for (int _i = 0; _i < 2; ++_i) \
        __builtin_amdgcn_global_load_lds((const unsigned*)((const char*)(gbase) + (voff)[_i]), (PG8_LAS unsigned*)(lds + (bufoff) + ldsw + _i * 8192), 16, 0, 0); } while (0)
#define PG8_LDA(dst, b, h) do { _Pragma("unroll") for (int m = 0; m < 4; ++m) _Pragma("unroll") for (int k = 0; k < 2; ++k) dst[m][k] = *(const PG8_LAS bf16x8*)(lds + PG8_SA(b, h) + aoff + m * 2048 + k * 1024); } while (0)
#define PG8_LDB(dst, b, h) do { _Pragma("unroll") for (int n = 0; n < 2; ++n) _Pragma("unroll") for (int k = 0; k < 2; ++k) dst[n][k] = *(const PG8_LAS bf16x8*)(lds + PG8_SB(b, h) + boff + n * 2048 + k * 1024); } while (0)
#define PG8_MMA(ai, bj, At, Bt) do { __builtin_amdgcn_s_setprio(1); _Pragma("unroll") for (int m = 0; m < 4; ++m) _Pragma("unroll") for (int n = 0; n < 2; ++n) _Pragma("unroll") for (int k = 0; k < 2; ++k) \
        acc[ai][bj][m][n] = __builtin_amdgcn_mfma_f32_16x16x32_bf16(Bt[n][k], At[m][k], acc[ai][bj][m][n], 0, 0, 0); __builtin_amdgcn_s_setprio(0); } while (0)
#define PG8_WAIT_V(n) asm volatile("s_waitcnt vmcnt(" #n ")" ::: "memory")
#define PG8_WAIT_L(n) asm volatile("s_waitcnt lgkmcnt(" #n ")" ::: "memory")
#define PG8_BAR __builtin_amdgcn_s_barrier()
#define PG8_SCHED __builtin_amdgcn_sched_barrier(0)
    Unit cur, nxt; int ui = 0;
    if (!S.next(0, cur)) return;
    f32x4 acc[2][2][4][2];
#pragma unroll
    for (int a = 0; a < 2; ++a)
#pragma unroll
        for (int b = 0; b < 2; ++b)
#pragma unroll
            for (int m = 0; m < 4; ++m)
#pragma unroll
                for (int n = 0; n < 2; ++n) acc[a][b][m][n] = (f32x4){0.f, 0.f, 0.f, 0.f};
    bf16x8 At[4][2], B0[2][2], B1[2][2];
    const char* cA = (const char*)g.A + (size_t)cur.pm * tstep; const char* cB = (const char*)g.Bt + (size_t)cur.pn * tstep;
    S.a_ready(cur);
    if constexpr (SP2) {
        PG8_STAGE(PG8_SB(0, 0), cB, voffB); PG8_STAGE(PG8_SB(0, 1), cB + hstep, voffB); PG8_STAGE(PG8_SA(0, 0), cA, voffA); PG8_STAGE(PG8_SA(0, 1), cA + hstep, voffA);
        if (wr == 1) PG8_BAR;
        PG8_WAIT_V(2); PG8_BAR;
        PG8_STAGE(PG8_SB(1, 0), cB + kstep, voffB); PG8_STAGE(PG8_SA(1, 0), cA + kstep, voffA); PG8_STAGE(PG8_SB(1, 1), cB + hstep + kstep, voffB);
        PG8_WAIT_V(6); PG8_BAR;
    } else {
        PG8_STAGE(PG8_SB(0, 0), cB, voffB); PG8_STAGE(PG8_SA(0, 0), cA, voffA); PG8_STAGE(PG8_SB(0, 1), cB + hstep, voffB); PG8_STAGE(PG8_SA(0, 1), cA + hstep, voffA);
        if (wr == 1) PG8_BAR;
        PG8_WAIT_V(4); PG8_BAR;
        PG8_STAGE(PG8_SB(1, 0), cB + kstep, voffB); PG8_STAGE(PG8_SA(1, 0), cA + kstep, voffA); PG8_STAGE(PG8_SB(1, 1), cB + hstep + kstep, voffB);
        PG8_WAIT_V(6); PG8_BAR;
    }
    for (;;) {
        const bool has_next = S.next(ui + 1, nxt);
        const char* nA = has_next ? (const char*)g.A + (size_t)nxt.pm * tstep : cA; const char* nB = has_next ? (const char*)g.Bt + (size_t)nxt.pn * tstep : cB;
        for (int t = 0; t < nt; t += 2) {
            const bool last = (t == nt - 2);
            const char* a1 = cA + (size_t)(t + 1) * kstep;
            const char* a2 = last ? nA : cA + (size_t)(t + 2) * kstep; const char* b2 = last ? nB : cB + (size_t)(t + 2) * kstep;
            const char* a3 = a2 + kstep; const char* b3 = b2 + kstep;
            if (last && has_next) S.a_ready(nxt);
            if constexpr (SP2) {
            PG8_LDB(B0, 0, 0); PG8_LDB(B1, 0, 1); PG8_SCHED; PG8_LDA(At, 0, 0); PG8_STAGE(PG8_SA(1, 1), a1 + hstep, voffA);
            PG8_WAIT_V(8); PG8_WAIT_L(0); PG8_BAR; PG8_MMA(0, 0, At, B0); PG8_MMA(0, 1, At, B1); PG8_BAR; PG8_SCHED;
            PG8_LDA(At, 0, 1); PG8_STAGE(PG8_SB(0, 0), b2, voffB); PG8_STAGE(PG8_SB(0, 1), b2 + hstep, voffB); PG8_STAGE(PG8_SA(0, 0), a2, voffA);
            PG8_WAIT_V(8); PG8_WAIT_L(0); PG8_BAR; PG8_MMA(1, 0, At, B0); PG8_MMA(1, 1, At, B1); PG8_BAR; PG8_SCHED;
            PG8_LDB(B0, 1, 0); PG8_LDB(B1, 1, 1); PG8_SCHED; PG8_LDA(At, 1, 0); PG8_STAGE(PG8_SA(0, 1), a2 + hstep, voffA);
            PG8_WAIT_V(8); PG8_WAIT_L(0); PG8_BAR; PG8_MMA(0, 0, At, B0); PG8_MMA(0, 1, At, B1); PG8_BAR; PG8_SCHED;
            PG8_LDA(At, 1, 1); PG8_STAGE(PG8_SB(1, 0), b3, voffB); PG8_STAGE(PG8_SB(1, 1), b3 + hstep, voffB); PG8_STAGE(PG8_SA(1, 0), a3, voffA);
            PG8_WAIT_V(8); PG8_WAIT_L(0); PG8_BAR; PG8_MMA(1, 0, At, B0); PG8_MMA(1, 1, At, B1); PG8_BAR; PG8_SCHED;
            } else {
            PG8_LDB(B0, 0, 0); PG8_SCHED; PG8_LDA(At, 0, 0); PG8_STAGE(PG8_SA(1, 1), a1 + hstep, voffA);
            PG8_WAIT_L(8); PG8_BAR; PG8_WAIT_L(0); PG8_MMA(0, 0, At, B0); PG8_BAR; PG8_SCHED;
            PG8_LDB(B1, 0, 1); PG8_STAGE(PG8_SB(0, 0), b2, voffB);
            PG8_BAR; PG8_WAIT_L(0); PG8_MMA(0, 1, At, B1); PG8_BAR;
            PG8_LDA(At, 0, 1); PG8_STAGE(PG8_SA(0, 0), a2, voffA);
            PG8_BAR; PG8_WAIT_L(0); PG8_MMA(1, 0, At, B0); PG8_BAR; PG8_SCHED;
            PG8_STAGE(PG8_SB(0, 1), b2 + hstep, voffB);
            PG8_WAIT_V(6); PG8_BAR; PG8_MMA(1, 1, At, B1); PG8_BAR;
            PG8_LDB(B0, 1, 0); PG8_SCHED; PG8_LDA(At, 1, 0); PG8_STAGE(PG8_SA(0, 1), a2 + hstep, voffA);
            PG8_WAIT_L(8); PG8_BAR; PG8_WAIT_L(0); PG8_MMA(0, 0, At, B0); PG8_BAR; PG8_SCHED;
            PG8_LDB(B1, 1, 1); PG8_STAGE(PG8_SB(1, 0), b3, voffB);
            PG8_BAR; PG8_WAIT_L(0); PG8_MMA(0, 1, At, B1); PG8_BAR;
            PG8_LDA(At, 1, 1); PG8_STAGE(PG8_SA(1, 0), a3, voffA);
            PG8_BAR; PG8_WAIT_L(0); PG8_MMA(1, 0, At, B0); PG8_BAR; PG8_SCHED;
            PG8_STAGE(PG8_SB(1, 1), b3 + hstep, voffB);
            PG8_WAIT_V(6); PG8_BAR; PG8_MMA(1, 1, At, B1); PG8_BAR;
            }
        }
        if constexpr (ALIGN_EPI) { if (wr == 0) PG8_BAR; }
        if constexpr (!Epi::AFTER_DRAIN) { E(acc, cur, wr, wc, fr, fq); S.done(cur); }
        if (!has_next) break;
#pragma unroll
        for (int a = 0; a < 2; ++a)
#pragma unroll
            for (int b = 0; b < 2; ++b)
#pragma unroll
                for (int m = 0; m < 4; ++m)
#pragma unroll
                    for (int n = 0; n < 2; ++n) acc[a][b][m][n] = (f32x4){0.f, 0.f, 0.f, 0.f};
        cur = nxt; cA = nA; cB = nB; ++ui;
        if constexpr (ALIGN_EPI) { if (wr == 1) PG8_BAR; }
    }
    PG8_WAIT_V(0);
    if constexpr (!ALIGN_EPI) { if (wr == 0) PG8_BAR; }
    PG8_BAR;
#undef PG8_SA
#undef PG8_SB
#undef PG8_STAGE
#undef PG8_LDA
#undef PG8_LDB
#undef PG8_MMA
#undef PG8_WAIT_V
#undef PG8_WAIT_L
#undef PG8_BAR
#undef PG8_SCHED
}
}

#define LAS __attribute__((address_space(3)))
typedef unsigned short bf16;
typedef short bf16x8 __attribute__((ext_vector_type(8)));
typedef short s16x4 __attribute__((ext_vector_type(4)));
typedef float f32x16 __attribute__((ext_vector_type(16)));
typedef float f32x4 __attribute__((ext_vector_type(4)));
typedef unsigned u32x4 __attribute__((ext_vector_type(4)));
typedef unsigned u32x2 __attribute__((ext_vector_type(2)));

constexpr int DM = 1024, INW = 2304, DFF = 2816, NTOK = 49152, NWAVES = 8;
constexpr float EPS = 1e-6f, LOG2E = 1.4426950408889634f, QSCALE = 0.125f * 1.4426950408889634f;
constexpr size_t MiB = 1u << 20;
constexpr size_t WS_MOD = 0, WS_LAM = 160 * 1024, WS_ROPE = 192 * 1024, WS_BAR = 512 * 1024, BAR_ZERO_BYTES = 16384;
constexpr size_t WS_WIN = 1 * MiB, WS_WOUT = 6 * MiB, WS_WGU = 8 * MiB, WS_WDN = 19 * MiB;
constexpr size_t WS_R1 = 25 * MiB;
constexpr size_t WS_RA = 121 * MiB;
constexpr size_t WS_RB = 337 * MiB;
constexpr size_t WS_END = 493 * MiB;
constexpr size_t WS_QG = WS_R1, WS_KG = WS_R1 + 48 * MiB, WS_VG = 481 * MiB;
constexpr size_t WS_QD = WS_RB, WS_KD = WS_RB + 48 * MiB, WS_VD = WS_RB + 96 * MiB;
constexpr size_t WS_H = WS_R1, WS_PROJ = WS_RA, WS_MIX = WS_RA, WS_O = WS_RA + 96 * MiB, WS_H2 = WS_R1, WS_ACT = WS_RA, WS_F = WS_R1;

constexpr int LDS_BYTES = 131072 + 1024;

struct Params {
    const float* in[22]; float* out; unsigned char* ws;
};

__device__ __forceinline__ int seq_of_row(int m) { return m < 32768 ? (m >> 14) : 2 + ((m - 32768) >> 12); }
__device__ __forceinline__ int seq_base(int s) { return s < 2 ? s * 16384 : 32768 + (s - 2) * 4096; }
__device__ __forceinline__ int seq_len(int s) { return s < 2 ? 16384 : 4096; }
__device__ __forceinline__ const float* x_row(const Params& P, int m) { return m < 32768 ? P.in[0] + (size_t)m * DM : P.in[1] + (size_t)(m - 32768) * DM; }

__device__ __forceinline__ unsigned f2bf(float f) { unsigned u = __builtin_bit_cast(unsigned, f); return (u + 0x7fffu + ((u >> 16) & 1u)) >> 16; }
__device__ __forceinline__ unsigned pk2(float lo, float hi) { return f2bf(lo) | (f2bf(hi) << 16); }
__device__ __forceinline__ float bf2f(unsigned short b) { return __builtin_bit_cast(float, (unsigned)b << 16); }
__device__ __forceinline__ float bflo(unsigned w) { return __builtin_bit_cast(float, w << 16); }
__device__ __forceinline__ float bfhi(unsigned w) { return __builtin_bit_cast(float, w & 0xffff0000u); }
__device__ __forceinline__ float wave_sum(float v) {
#pragma unroll
    for (int o = 1; o < 64; o <<= 1) v += __shfl_xor(v, o);
    return v;
}
__device__ __forceinline__ void wave_sum4(float (&v)[4]) {
#pragma unroll
    for (int o = 1; o < 64; o <<= 1) { float t[4];
#pragma unroll
        for (int r = 0; r < 4; ++r) t[r] = __shfl_xor(v[r], o);
#pragma unroll
        for (int r = 0; r < 4; ++r) v[r] += t[r]; }
}

__device__ __forceinline__ int k_img(int key, int d) { return (d >> 4) * 2048 + ((d >> 3) & 1) * 1024 + (key >> 5) * 512 + (key & 31) * 16 + (d & 7) * 2; }
template <int NCB> __device__ __forceinline__ int v_img(int k, int c) { const int kk = k; return ((kk >> 3) * NCB + (c >> 5)) * 512 + ((kk & 7) * 32 + (c & 31)) * 2; }
__device__ __forceinline__ int v_rd_base(int lane) { return ((lane & 3) << 3) | (((lane >> 2) & 3) << 6) | (((lane >> 4) & 1) << 5) | (((lane >> 5) & 1) << 8); }

struct EpiProj {
    static constexpr bool PERM = true, AFTER_DRAIN = false;
    bf16* O; int ldc; unsigned char* ws;
    __device__ __forceinline__ void operator()(const pg8::f32x4 (&acc)[2][2][4][2], const pg8::Unit& u, int wr, int wc, int fr, int fq) const {
        const int row0 = u.pm * 256 + wr * 64 + fr;
#pragma unroll
        for (int ai = 0; ai < 2; ++ai)
#pragma unroll
            for (int m = 0; m < 4; ++m) {
                const int row = row0 + ai * 128 + m * 16;
                const int s = seq_of_row(row), sb = seq_base(s), n = seq_len(s), t = row - sb, tile = t >> 6, key = t & 63;
#pragma unroll
                for (int bj = 0; bj < 2; ++bj) {
                    const int cb = u.pn * 256 + bj * 128;
                    const int c = cb + wc * 32 + 8 * fq;
                    pg8::f32x4 v0 = acc[ai][bj][m][0], v1 = acc[ai][bj][m][1];
                    if (cb >= 768 && cb < 1280) { v0 = v0 * QSCALE; v1 = v1 * QSCALE; }
                    u32x4 w; w.x = pg8::cvt_pk_bf16(v0[0], v0[1]); w.y = pg8::cvt_pk_bf16(v0[2], v0[3]); w.z = pg8::cvt_pk_bf16(v1[0], v1[1]); w.w = pg8::cvt_pk_bf16(v1[2], v1[3]);
                    if (cb < 640) *(u32x4*)(O + (size_t)row * ldc + c) = w;
                    else if (cb < 768) { const int cc = c - 640; *(u32x4*)(ws + WS_VG + ((size_t)sb * 2 + (size_t)(cc >> 6) * n) * 128 + (size_t)tile * 8192 + v_img<2>(key, cc & 63)) = w; }
                    else if (cb < 1280) { const int cc = c - 768; *(u32x4*)(ws + WS_QD + ((size_t)sb * 8 + (size_t)(cc >> 6) * n + t) * 128 + (cc & 63) * 2) = w; }
                    else if (cb < 1792) { const int cc = c - 1280; *(u32x4*)(ws + WS_KD + ((size_t)sb * 8 + (size_t)(cc >> 6) * n) * 128 + (size_t)tile * 8192 + k_img(key, cc & 63)) = w; }
                    else { const int cc = c - 1792; *(u32x4*)(ws + WS_VD + ((size_t)sb * 4 + (size_t)(cc >> 7) * n) * 256 + (size_t)tile * 16384 + v_img<4>(key, cc & 127)) = w; }
                }
            }
    }
};

namespace att {
#define SBAR() __builtin_amdgcn_sched_barrier(0)
constexpr float THR = 8.f;
constexpr int SHM_V = 16384, SHM_K = 8192, NSLOT = 3;
constexpr int L_V = 0, L_K = NSLOT * SHM_V, L_WS = L_K + NSLOT * SHM_K, L_TAB = L_WS + NWAVES * 64 * 4, L_END = L_TAB + 2048;
static_assert(L_END <= 131072, "attention LDS");
__device__ __forceinline__ int crow(int r, int hi) { return (r & 3) + 8 * (r >> 2) + 4 * hi; }
__device__ __forceinline__ unsigned cvtpk(float lo, float hi) { unsigned r; asm volatile("v_cvt_pk_bf16_f32 %0, %1, %2" : "=v"(r) : "v"(lo), "v"(hi)); return r; }
__device__ __forceinline__ float max3f(float a, float b, float c) { float r; asm("v_max3_f32 %0, %1, %2, %3" : "=v"(r) : "v"(a), "v"(b), "v"(c)); return r; }
__device__ __forceinline__ void glds16(const void* gbase  , unsigned voff, unsigned lds_dst) { unsigned keep;
    asm volatile("s_mov_b32 %0, m0\n\ts_mov_b32 m0, %3\n\ts_nop 0\n\tglobal_load_lds_dwordx4 %1, %2\n\ts_mov_b32 m0, %0" : "=&s"(keep) : "v"(voff), "s"(gbase), "s"(lds_dst) : "memory"); }
#define WAIT_BAR() asm volatile("s_waitcnt vmcnt(0) lgkmcnt(0)\n\ts_barrier" ::: "memory")

template <bool BIAS, bool FIRST>
__device__ __forceinline__ void partialSM(f32x16& p0, f32x16& p1, float& m_reg, float& alpha, bool& moved, int bmode, const LAS float* tab, int idx0) {
    if constexpr (BIAS) {
        if (bmode == 2) {
#pragma unroll
            for (int r = 0; r < 16; ++r) { const int o = (r & 3) + 8 * (r >> 2); p0[r] += tab[idx0 + o]; p1[r] += tab[idx0 + 32 + o]; }
        }
    }
    float a = max3f(p0[0], p0[1], p1[0]), b = max3f(p0[2], p0[3], p1[1]); a = max3f(a, p1[2], p1[3]);
#pragma unroll
    for (int r = 4; r < 16; r += 4) { a = max3f(a, p0[r], p0[r + 1]); b = max3f(b, p0[r + 2], p0[r + 3]); a = max3f(a, p1[r], p1[r + 1]); b = max3f(b, p1[r + 2], p1[r + 3]); }
    float pmax = fmaxf(a, b);
    { auto rr = __builtin_amdgcn_permlane32_swap(__float_as_uint(pmax), __float_as_uint(pmax), false, false);
      pmax = fmaxf(__uint_as_float(rr[0]), __uint_as_float(rr[1])); }
    moved = false; alpha = 1.f;
    if (FIRST || !__builtin_expect(__all(pmax <= THR), 1)) {
        const float dl = FIRST ? pmax : fmaxf(pmax, 0.f);
        m_reg += dl; moved = true;
        if (!FIRST) alpha = __builtin_amdgcn_exp2f(-dl);
#pragma unroll
        for (int r = 0; r < 16; ++r) { p0[r] -= dl; p1[r] -= dl; }
    }
#pragma unroll
    for (int r = 0; r < 16; ++r) p0[r] = __builtin_amdgcn_exp2f(p0[r]);
}
__device__ __forceinline__ void finishSM(f32x16& p0, f32x16& p1, float alpha, float& l_reg, bf16x8& pa0, bf16x8& pa1, bf16x8& pa2, bf16x8& pa3) {
#pragma unroll
    for (int r = 0; r < 16; ++r) p1[r] = __builtin_amdgcn_exp2f(p1[r]);
    float ps = 0;
#pragma unroll
    for (int r = 0; r < 16; ++r) ps += p0[r];
#pragma unroll
    for (int r = 0; r < 16; ++r) ps += p1[r];
    { auto rr = __builtin_amdgcn_permlane32_swap(__float_as_uint(ps), __float_as_uint(ps), false, false);
      ps = __uint_as_float(rr[0]) + __uint_as_float(rr[1]); }
    l_reg = l_reg * alpha + ps;
#define PK4(P, BASE, OUT) do { unsigned a0 = cvtpk(P[BASE + 0], P[BASE + 1]), a1 = cvtpk(P[BASE + 2], P[BASE + 3]);   \
    unsigned b0 = cvtpk(P[BASE + 4], P[BASE + 5]), b1 = cvtpk(P[BASE + 6], P[BASE + 7]);                              \
    auto r0 = __builtin_amdgcn_permlane32_swap(a0, b0, false, false); auto r1 = __builtin_amdgcn_permlane32_swap(a1, b1, false, false); \
    u32x4 w = {r0[0], r1[0], r0[1], r1[1]}; OUT = __builtin_bit_cast(bf16x8, w); } while (0)
    PK4(p0, 0, pa0); PK4(p0, 8, pa1); PK4(p1, 0, pa2); PK4(p1, 8, pa3);
#undef PK4
}
__device__ __forceinline__ void qkt(f32x16& p0, f32x16& p1, const LAS char* Ks, const bf16x8* qr, const f32x16& negm, int r32, int hi) {
    const LAS char* kb = Ks + hi * 1024 + r32 * 16;
#pragma unroll
    for (int d0 = 0; d0 < 4; ++d0) {
        const bf16x8 b0 = *(const LAS bf16x8*)(kb + d0 * 2048);
        const bf16x8 b1 = *(const LAS bf16x8*)(kb + d0 * 2048 + 512);
        if (d0 == 0) { p0 = __builtin_amdgcn_mfma_f32_32x32x16_bf16(b0, qr[0], negm, 0, 0, 0); p1 = __builtin_amdgcn_mfma_f32_32x32x16_bf16(b1, qr[0], negm, 0, 0, 0); }
        else { p0 = __builtin_amdgcn_mfma_f32_32x32x16_bf16(b0, qr[d0], p0, 0, 0, 0); p1 = __builtin_amdgcn_mfma_f32_32x32x16_bf16(b1, qr[d0], p1, 0, 0, 0); } }
}
template <int OFF> __device__ __forceinline__ s16x4 tr_read(int vb) {
    s16x4 r; asm volatile("ds_read_b64_tr_b16 %0, %1 offset:%2" : "=&v"(r) : "v"(vb), "i"(OFF) : "memory"); return r;
}
template <int NCB> constexpr int v_rd_off(int d0, int ks, int half) { return d0 * 512 + (2 * ks + half) * NCB * 512; }
template <int NCB, int D0> __device__ __forceinline__ void pv_one(f32x16& od, int vb, bf16x8 pa0, bf16x8 pa1, bf16x8 pa2, bf16x8 pa3) {
    const s16x4 l0 = tr_read<v_rd_off<NCB>(D0, 0, 0)>(vb), h0 = tr_read<v_rd_off<NCB>(D0, 0, 1)>(vb), l1 = tr_read<v_rd_off<NCB>(D0, 1, 0)>(vb), h1 = tr_read<v_rd_off<NCB>(D0, 1, 1)>(vb);
    const s16x4 l2 = tr_read<v_rd_off<NCB>(D0, 2, 0)>(vb), h2 = tr_read<v_rd_off<NCB>(D0, 2, 1)>(vb), l3 = tr_read<v_rd_off<NCB>(D0, 3, 0)>(vb), h3 = tr_read<v_rd_off<NCB>(D0, 3, 1)>(vb);
    asm volatile("s_waitcnt lgkmcnt(0)" ::: "memory"); SBAR();
#define PK(L, H) (bf16x8){L[0], L[1], L[2], L[3], H[0], H[1], H[2], H[3]}
    od = __builtin_amdgcn_mfma_f32_32x32x16_bf16(pa0, PK(l0, h0), od, 0, 0, 0);
    od = __builtin_amdgcn_mfma_f32_32x32x16_bf16(pa1, PK(l1, h1), od, 0, 0, 0);
    od = __builtin_amdgcn_mfma_f32_32x32x16_bf16(pa2, PK(l2, h2), od, 0, 0, 0);
    od = __builtin_amdgcn_mfma_f32_32x32x16_bf16(pa3, PK(l3, h3), od, 0, 0, 0);
#undef PK
}
template <int NCB> __device__ __forceinline__ void pv_all(f32x16* o, int vb, bf16x8 pa0, bf16x8 pa1, bf16x8 pa2, bf16x8 pa3) {
    pv_one<NCB, 0>(o[0], vb, pa0, pa1, pa2, pa3); pv_one<NCB, 1>(o[1], vb, pa0, pa1, pa2, pa3);
    if constexpr (NCB == 4) { pv_one<NCB, 2>(o[2], vb, pa0, pa1, pa2, pa3); pv_one<NCB, 3>(o[3], vb, pa0, pa1, pa2, pa3); }
}

template <int NCB, bool DIFF>
__device__ __forceinline__ void attn_unit(LAS char* lds, const Params& P, int s, int head, int qb) {
    constexpr int NMAP = DIFF ? 2 : 1;
    constexpr int VB = NCB * 4096;
    int tid_ = threadIdx.x; asm volatile("" : "+v"(tid_));
    const int tid = tid_, lane = tid & 63, r32 = lane & 31, hi = lane >> 5; const int wid = __builtin_amdgcn_readfirstlane(tid >> 6);
    const int n = seq_len(s), sb = seq_base(s), NT = n >> 6, q0 = qb * 256;
    LAS float* wsf = (LAS float*)(lds + L_WS) + wid * 64; LAS float* li_l = wsf; LAS float* al_l = wsf + 32;
    LAS float* tab = (LAS float*)(lds + L_TAB);
    const unsigned lds0 = (unsigned)(uintptr_t)lds;
    const int vb0 = (int)(lds0 + L_V) + v_rd_base(lane);
    unsigned char* ws = P.ws;
    f32x16 o[NCB];
    float bL = 0.f, bR = 0.f;
    if constexpr (DIFF) {
        __syncthreads();
        { const int rel = tid - 256; const int nn = rel < 0 ? -rel : rel;
          int b = nn < 8 ? nn : (2 + (31 - __builtin_clz((unsigned)(nn * nn)))); b = b > 15 ? 15 : b; if (rel > 0) b += 16;
          tab[tid] = P.in[4][b * 4 + head] * LOG2E; }
        bL = P.in[4][15 * 4 + head] * LOG2E; bR = P.in[4][31 * 4 + head] * LOG2E;
    }
    const int qw = q0 + wid * 32;
#pragma unroll 1
    for (int mp = 0; mp < NMAP; ++mp) {
        const bf16* Qw; const unsigned char* Kimg; const unsigned char* Vimg;
        if constexpr (DIFF) {
            Qw = (const bf16*)(ws + WS_QD) + ((size_t)sb * 8 + (size_t)(head * 2 + mp) * n + qw) * 64;
            Kimg = ws + WS_KD + ((size_t)sb * 8 + (size_t)(head * 2 + mp) * n) * 128;
            Vimg = ws + WS_VD + ((size_t)sb * 4 + (size_t)head * n) * 256;
        } else {
            Qw = (const bf16*)(ws + WS_QG) + ((size_t)sb * 8 + (size_t)head * n + qw) * 64;
            Kimg = ws + WS_KG + ((size_t)sb * 2 + (size_t)(head >> 2) * n) * 128;
            Vimg = ws + WS_VG + ((size_t)sb * 2 + (size_t)(head >> 2) * n) * 128;
        }
        const unsigned dvoff = (unsigned)(wid * 1024 + lane * 16);
        const unsigned kdst = lds0 + L_K + wid * 1024, vdst = lds0 + L_V + wid * 1024;
#define DMA(t, slot) do { glds16(Kimg + (size_t)(t) * 8192, dvoff, (unsigned)__builtin_amdgcn_readfirstlane(kdst + (slot) * SHM_K)); \
        glds16(Vimg + (size_t)(t) * VB, dvoff, (unsigned)__builtin_amdgcn_readfirstlane(vdst + (slot) * SHM_V)); \
        if constexpr (NCB == 4) glds16(Vimg + (size_t)(t) * VB + 8192, dvoff, (unsigned)__builtin_amdgcn_readfirstlane(vdst + (slot) * SHM_V + 8192)); } while (0)
#define RESC(a) do { if (__any((a) < 1.f)) { if (hi == 0) al_l[r32] = (a); asm volatile("s_waitcnt lgkmcnt(0)" ::: "memory"); \
        _Pragma("unroll") for (int d = 0; d < NCB; ++d) _Pragma("unroll") for (int r = 0; r < 16; ++r) o[d][r] *= al_l[crow(r, hi)]; } } while (0)
#define BMODE(t) do { if constexpr (DIFF) { const int dd = (t) * 64 - qw; float cbn; if (dd <= -191) { bm = 1; cbn = bL; } else if (dd >= 159) { bm = 1; cbn = bR; } else { bm = 2; cbn = 0.f; } \
            ix = dd - r32 + 256 + 4 * hi; if (cbn != cb) { cb = cbn; moved = true; } } } while (0)
#define NEGM() do { if (moved) { const float v_ = cb - m_reg; _Pragma("unroll") for (int r = 0; r < 16; ++r) negm[r] = v_; asm volatile("" : "+v"(negm)); } } while (0)
        __syncthreads();
        DMA(0, 0); DMA(1, 1);
        bf16x8 qr[4];
#pragma unroll
        for (int d0 = 0; d0 < 4; ++d0) qr[d0] = *(const bf16x8*)(Qw + (size_t)r32 * 64 + d0 * 16 + hi * 8);
        float m_reg = 0.f, l_reg = 0.f, cb = 0.f; bool moved = true;
        f32x16 negm;
#pragma unroll
        for (int d = 0; d < NCB; ++d) o[d] = f32x16{};
        f32x16 pA0, pA1, pB0, pB1; float alA = 1.f, alB = 1.f; bf16x8 pa0, pa1, pa2, pa3;
        int bm = 0, ix = 0;
        WAIT_BAR();
        if (2 < NT) DMA(2, 2);
        BMODE(0); NEGM();
        qkt(pA0, pA1, lds + L_K, qr, negm, r32, hi); partialSM<DIFF, true>(pA0, pA1, m_reg, alA, moved, bm, tab, ix);
        int sl_prev = 0, sl_cur = 1, sl_next = 2;
#define ROT() do { const int t_ = sl_prev; sl_prev = sl_cur; sl_cur = sl_next; sl_next = t_; } while (0)
#define STEP(C0, C1, alC, P0, P1, alP, j) do { \
            BMODE(j); NEGM(); SBAR(); \
            qkt(C0, C1, lds + L_K + sl_cur * SHM_K, qr, negm, r32, hi); \
            finishSM(P0, P1, alP, l_reg, pa0, pa1, pa2, pa3); SBAR(); \
            pv_all<NCB>(o, vb0 + sl_prev * SHM_V, pa0, pa1, pa2, pa3); \
            partialSM<DIFF, false>(C0, C1, m_reg, alC, moved, bm, tab, ix); \
            WAIT_BAR(); \
            if ((j) + 2 < NT) DMA((j) + 2, sl_prev); \
            RESC(alC); ROT(); } while (0)
        for (int j = 1; j + 1 < NT; j += 2) {
            STEP(pB0, pB1, alB, pA0, pA1, alA, j);
            STEP(pA0, pA1, alA, pB0, pB1, alB, j + 1);
        }
        STEP(pB0, pB1, alB, pA0, pA1, alA, NT - 1);
        finishSM(pB0, pB1, alB, l_reg, pa0, pa1, pa2, pa3); SBAR();
        pv_all<NCB>(o, vb0 + sl_prev * SHM_V, pa0, pa1, pa2, pa3);
#undef DMA
#undef RESC
#undef BMODE
#undef NEGM
#undef ROT
#undef STEP
        if (hi == 0) li_l[r32] = l_reg; asm volatile("s_waitcnt lgkmcnt(0)" ::: "memory");
        float rli[16];
#pragma unroll
        for (int r = 0; r < 16; ++r) rli[r] = __builtin_amdgcn_rcpf(li_l[crow(r, hi)]);
        bf16* mixw = (bf16*)(ws + WS_MIX) + (size_t)(sb + qw) * DM;
        if constexpr (!DIFF) {
#pragma unroll
            for (int r = 0; r < 16; ++r) { const int orow = crow(r, hi);
#pragma unroll
                for (int d0 = 0; d0 < NCB; ++d0) mixw[(size_t)orow * DM + head * 64 + d0 * 32 + r32] = (bf16)f2bf(o[d0][r] * rli[r]); }
        } else {
            if (mp == 0) {
#pragma unroll
                for (int r = 0; r < 16; ++r) { const int orow = crow(r, hi);
#pragma unroll
                    for (int d0 = 0; d0 < NCB; ++d0) mixw[(size_t)orow * DM + 512 + head * 128 + d0 * 32 + r32] = (bf16)f2bf(o[d0][r] * rli[r]); }
            } else {
                const float lam = *(const float*)(ws + WS_LAM);
                float ss[16];
#pragma unroll
                for (int r = 0; r < 16; ++r) ss[r] = 0.f;
#pragma unroll
                for (int d0 = 0; d0 < NCB; ++d0)
#pragma unroll
                    for (int r = 0; r < 16; ++r) { const float o1 = bf2f(mixw[(size_t)crow(r, hi) * DM + 512 + head * 128 + d0 * 32 + r32]);
                        const float a0 = o1 - lam * (o[d0][r] * rli[r]); o[d0][r] = a0; ss[r] += a0 * a0; }
#pragma unroll
                for (int r = 0; r < 16; ++r) {
#pragma unroll
                    for (int of = 1; of < 32; of <<= 1) ss[r] += __shfl_xor(ss[r], of);
                    ss[r] = __builtin_amdgcn_rsqf(ss[r] * (1.0f / 128.0f) + EPS) * 0.8f;
                }
                float gs[NCB];
#pragma unroll
                for (int d0 = 0; d0 < NCB; ++d0) gs[d0] = P.in[15][d0 * 32 + r32];
#pragma unroll
                for (int r = 0; r < 16; ++r) { const int orow = crow(r, hi);
#pragma unroll
                    for (int d0 = 0; d0 < NCB; ++d0) mixw[(size_t)orow * DM + 512 + head * 128 + d0 * 32 + r32] = (bf16)f2bf(o[d0][r] * ss[r] * gs[d0]); }
            }
        }
    }
}
#undef SBAR
#undef WAIT_BAR
}

namespace att2 {
#define SBAR() __builtin_amdgcn_sched_barrier(0)
constexpr float THR = 8.f;
constexpr int SHM_V = 16384, SHM_K = 8192, NSLOT = 5;
constexpr int L_V = 0, L_K = NSLOT * SHM_V, L_WS = L_K + NSLOT * SHM_K, L_TAB = L_WS + NWAVES * 64 * 4, L_END = L_TAB + 2048;
static_assert(L_END <= 131072, "attention LDS");
__device__ __forceinline__ int crow(int r, int hi) { return (r & 3) + 8 * (r >> 2) + 4 * hi; }
__device__ __forceinline__ unsigned cvtpk(float lo, float hi) { unsigned r; asm volatile("v_cvt_pk_bf16_f32 %0, %1, %2" : "=v"(r) : "v"(lo), "v"(hi)); return r; }
__device__ __forceinline__ float max3f(float a, float b, float c) { float r; asm("v_max3_f32 %0, %1, %2, %3" : "=v"(r) : "v"(a), "v"(b), "v"(c)); return r; }
__device__ __forceinline__ void glds16(const void* gbase, unsigned voff, unsigned lds_dst) { unsigned keep;
    asm volatile("s_mov_b32 %0, m0\n\ts_mov_b32 m0, %3\n\ts_nop 0\n\tglobal_load_lds_dwordx4 %1, %2\n\ts_mov_b32 m0, %0" : "=&s"(keep) : "v"(voff), "s"(gbase), "s"(lds_dst) : "memory"); }
#define WAIT_BAR() asm volatile("s_waitcnt vmcnt(0) lgkmcnt(0)\n\ts_barrier" ::: "memory")

template <bool BIAS>
__device__ __forceinline__ void bias_add(f32x16& p0, f32x16& p1, int bmode, const LAS float* tab, int idx0) {
    if constexpr (BIAS) {
        if (bmode == 2) {
#pragma unroll
            for (int r = 0; r < 16; ++r) { const int o = (r & 3) + 8 * (r >> 2); p0[r] += tab[idx0 + o]; p1[r] += tab[idx0 + 32 + o]; if ((r & 3) == 3) { asm volatile("" : "+v"(p0), "+v"(p1)); SBAR(); } }
        }
    }
}
template <bool BIAS, bool FIRST>
__device__ __forceinline__ void rowmax_decide(f32x16& p0, f32x16& p1, float& m_reg, float& alpha, bool& moved, int bmode, const LAS float* tab, int idx0) {
    float a = max3f(p0[0], p0[1], p1[0]), b = max3f(p0[2], p0[3], p1[1]); a = max3f(a, p1[2], p1[3]);
#pragma unroll
    for (int r = 4; r < 16; r += 4) { a = max3f(a, p0[r], p0[r + 1]); b = max3f(b, p0[r + 2], p0[r + 3]); a = max3f(a, p1[r], p1[r + 1]); b = max3f(b, p1[r + 2], p1[r + 3]); }
    float pmax = fmaxf(a, b);
    { auto rr = __builtin_amdgcn_permlane32_swap(__float_as_uint(pmax), __float_as_uint(pmax), false, false);
      pmax = fmaxf(__uint_as_float(rr[0]), __uint_as_float(rr[1])); }
    moved = false; alpha = 1.f;
    if (FIRST || !__builtin_expect(__all(pmax <= THR), 1)) {
        const float dl = FIRST ? pmax : fmaxf(pmax, 0.f);
        m_reg += dl; moved = true;
        if (!FIRST) alpha = __builtin_amdgcn_exp2f(-dl);
#pragma unroll
        for (int r = 0; r < 16; ++r) { p0[r] -= dl; p1[r] -= dl; }
    }
}
__device__ __forceinline__ s16x4 tr_rd(const LAS char* p) {
    typedef short v4i16_t __attribute__((ext_vector_type(4)));
    return __builtin_bit_cast(s16x4, __builtin_amdgcn_ds_read_tr16_b64_v4i16((LAS v4i16_t*)p));
}
#define PKV(L, H) (bf16x8){L[0], L[1], L[2], L[3], H[0], H[1], H[2], H[3]}
#define PKW(P, B) cvtpk(P[B], P[B + 1])
#define MFMA32(a, b, c) __builtin_amdgcn_mfma_f32_32x32x16_bf16(a, b, c, 0, 0, 0)

template <int NCB, bool DIFF, bool STAT>
__device__ __forceinline__ void attn_unit(LAS char* lds, const Params& P, int s, int head, int qb, float sref) {
    constexpr int NMAP = DIFF ? 2 : 1;
    constexpr int VB = NCB * 4096;
    constexpr int NG = 4 * NCB, EPG = 32 / NG;
    constexpr bool KJ = (NCB == 4);
    int tid_ = threadIdx.x; asm volatile("" : "+v"(tid_));
    const int tid = tid_, lane = tid & 63, r32 = lane & 31, hi = lane >> 5; const int wid = __builtin_amdgcn_readfirstlane(tid >> 6);
    const int n = seq_len(s), sb = seq_base(s), NT = n >> 6, q0 = qb * 256;
    LAS float* wsf = (LAS float*)(lds + L_WS) + wid * 64; LAS float* li_l = wsf; LAS float* al_l = wsf + 32;
    LAS float* tab = (LAS float*)(lds + L_TAB);
    const unsigned lds0 = (unsigned)(uintptr_t)lds;
    const LAS char* vp0 = lds + L_V + v_rd_base(lane);
    const LAS char* kp0 = lds + L_K + hi * 1024 + r32 * 16;
    unsigned char* ws = P.ws;
    f32x16 o[NCB];
    float bL = 0.f, bR = 0.f;
    if constexpr (DIFF) {
        __syncthreads();
        { const int rel = tid - 256; const int nn = rel < 0 ? -rel : rel;
          int b = nn < 8 ? nn : (2 + (31 - __builtin_clz((unsigned)(nn * nn)))); b = b > 15 ? 15 : b; if (rel > 0) b += 16;
          tab[tid] = P.in[4][b * 4 + head] * LOG2E; }
        bL = P.in[4][15 * 4 + head] * LOG2E; bR = P.in[4][31 * 4 + head] * LOG2E;
    }
    const int qw = q0 + wid * 32;
#pragma unroll 1
    for (int mp = 0; mp < NMAP; ++mp) {
        const bf16* Qw; const unsigned char* Kimg; const unsigned char* Vimg;
        if constexpr (DIFF) {
            Qw = (const bf16*)(ws + WS_QD) + ((size_t)sb * 8 + (size_t)(head * 2 + mp) * n + qw) * 64;
            Kimg = ws + WS_KD + ((size_t)sb * 8 + (size_t)(head * 2 + mp) * n) * 128;
            Vimg = ws + WS_VD + ((size_t)sb * 4 + (size_t)head * n) * 256;
        } else {
            Qw = (const bf16*)(ws + WS_QG) + ((size_t)sb * 8 + (size_t)head * n + qw) * 64;
            Kimg = ws + WS_KG + ((size_t)sb * 2 + (size_t)(head >> 2) * n) * 128;
            Vimg = ws + WS_VG + ((size_t)sb * 2 + (size_t)(head >> 2) * n) * 128;
        }
        const unsigned dvoff = (unsigned)(wid * 1024 + lane * 16);
        const unsigned kdst = lds0 + L_K + wid * 1024, vdst = lds0 + L_V + wid * 1024;
#define DMA(t, slot) do { glds16(Kimg + (size_t)(t) * 8192, dvoff, (unsigned)__builtin_amdgcn_readfirstlane(kdst + (slot) * SHM_K)); \
        glds16(Vimg + (size_t)(t) * VB, dvoff, (unsigned)__builtin_amdgcn_readfirstlane(vdst + (slot) * SHM_V)); \
        if constexpr (NCB == 4) glds16(Vimg + (size_t)(t) * VB + 8192, dvoff, (unsigned)__builtin_amdgcn_readfirstlane(vdst + (slot) * SHM_V + 8192)); } while (0)
#define RESC(a) do { if (__any((a) < 1.f)) { if (hi == 0) al_l[r32] = (a); asm volatile("s_waitcnt lgkmcnt(0)" ::: "memory"); \
        _Pragma("unroll") for (int d = 0; d < NCB; ++d) _Pragma("unroll") for (int r = 0; r < 16; ++r) o[d][r] *= al_l[crow(r, hi)]; } } while (0)
#define BMODE(t) do { if constexpr (DIFF) { const int dd = (t) * 64 - qw; float cbn; if (dd <= -191) { bm = 1; cbn = bL; } else if (dd >= 159) { bm = 1; cbn = bR; } else { bm = 2; cbn = 0.f; } \
            ix = dd - r32 + 256 + 4 * hi; if (cbn != cb) { cb = cbn; moved = true; } } } while (0)
#define NEGM() do { if (moved) { const float v_ = cb - m_reg; _Pragma("unroll") for (int r = 0; r < 16; ++r) negm[r] = v_; asm volatile("" : "+v"(negm)); } } while (0)
        __syncthreads();
        DMA(0, 0); DMA(1, 1); DMA(2, 2);
        bf16x8 qr[4];
#pragma unroll
        for (int d0 = 0; d0 < 4; ++d0) qr[d0] = *(const bf16x8*)(Qw + (size_t)r32 * 64 + d0 * 16 + hi * 8);
        float m_reg = STAT ? sref : 0.f, l_reg = 0.f, cb = 0.f; bool moved = true;
        if constexpr (STAT && DIFF) {
            float q2 = 0.f;
#pragma unroll
            for (int d0 = 0; d0 < 4; ++d0)
#pragma unroll
                for (int i = 0; i < 8; ++i) { const float f = __builtin_bit_cast(float, (unsigned)(unsigned short)qr[d0][i] << 16); q2 += f * f; }
            { auto rr = __builtin_amdgcn_permlane32_swap(__float_as_uint(q2), __float_as_uint(q2), false, false); q2 = __uint_as_float(rr[0]) + __uint_as_float(rr[1]); }
            const float kn2 = __uint_as_float(((const unsigned*)(ws + WS_BAR))[3800 + s * 8 + head * 2 + mp]);
            m_reg = __builtin_sqrtf(q2 * kn2) * 1.001f + 0.01f + sref;
        }
        f32x16 negm;
#pragma unroll
        for (int d = 0; d < NCB; ++d) o[d] = f32x16{};
        f32x16 pA0, pA1, pB0, pB1; float alA = 1.f, alB = 1.f;
        u32x4 pw[4];
        int bm = 0, ix = 0;
        WAIT_BAR();
        BMODE(0); NEGM();
        { const LAS char* kp_ = kp0;
#pragma unroll
          for (int d0 = 0; d0 < 4; ++d0) { const bf16x8 b0 = *(const LAS bf16x8*)(kp_ + d0 * 2048), b1 = *(const LAS bf16x8*)(kp_ + d0 * 2048 + 512);
              if (d0 == 0) { pA0 = MFMA32(b0, qr[0], negm); pA1 = MFMA32(b1, qr[0], negm); } else { pA0 = MFMA32(b0, qr[d0], pA0); pA1 = MFMA32(b1, qr[d0], pA1); } } }
        bias_add<DIFF>(pA0, pA1, bm, tab, ix);
        if constexpr (!STAT) rowmax_decide<DIFF, true>(pA0, pA1, m_reg, alA, moved, bm, tab, ix); else moved = false;
#pragma unroll
        for (int r = 0; r < 16; ++r) { pA0[r] = __builtin_amdgcn_exp2f(pA0[r]); pA1[r] = __builtin_amdgcn_exp2f(pA1[r]); }
        int sl_prev = 0, sl_cur = 1;
        bf16x8 kf[3];
#define ROT() do { sl_prev = sl_cur; sl_cur = (sl_cur == 4) ? 0 : sl_cur + 1; } while (0)
#define ADD5(x, k) (((x) + (k) >= 5) ? (x) + (k) - 5 : (x) + (k))
#define KRD(g) do { kf[(g) % 3] = *(const LAS bf16x8*)(kp_ + ((g) >> 1) * 2048 + ((g) & 1) * 512); } while (0)
#define VRD(g) do { const int o_ = ((g) % NCB) * 512 + (2 * ((g) / NCB)) * NCB * 512; vl[(g) % 3] = tr_rd(vp_ + o_); vh[(g) % 3] = tr_rd(vp_ + o_ + NCB * 512); } while (0)
#define STEP(C0, C1, alC, P0, P1, alP, j, WB, KPRE) do { \
            BMODE(j); NEGM(); SBAR(); \
            const LAS char* kp_ = kp0 + sl_cur * SHM_K; const LAS char* vp_ = vp0 + sl_prev * SHM_V; \
            s16x4 vl[3], vh[3]; \
            if (!(KPRE)) { KRD(0); KRD(1); } \
            float s0_ = 0.f, s1_ = 0.f; \
            SBAR(); \
            _Pragma("unroll") for (int g = 0; g < 8; ++g) { \
                if (g + 2 < 8) KRD(g + 2); \
                if ((g & 1) == 0) C0 = MFMA32(kf[g % 3], qr[g >> 1], (g < 2) ? negm : C0); else C1 = MFMA32(kf[g % 3], qr[g >> 1], (g < 2) ? negm : C1); \
                if (g < 4) { s0_ += P0[4 * g]; s1_ += P0[4 * g + 1]; s0_ += P0[4 * g + 2]; s1_ += P0[4 * g + 3]; \
                             pw[g >> 1][(g & 1) * 2] = PKW(P0, 4 * g); pw[g >> 1][(g & 1) * 2 + 1] = PKW(P0, 4 * g + 2); } \
                else { s0_ += P1[4 * g - 16]; s1_ += P1[4 * g - 15]; s0_ += P1[4 * g - 14]; s1_ += P1[4 * g - 13]; \
                       pw[g >> 1][(g & 1) * 2] = PKW(P1, 4 * g - 16); pw[g >> 1][(g & 1) * 2 + 1] = PKW(P1, 4 * g - 14); } \
                asm volatile("" : "+v"(s0_), "+v"(s1_)); \
                if (g == 6) VRD(0); if (g == 7) VRD(1); \
                SBAR(); } \
            if constexpr (STAT) l_reg += (s0_ + s1_); else l_reg = l_reg * alP + (s0_ + s1_); \
            if (!(WB)) { if ((j) + 2 < NT) DMA((j) + 2, ADD5(sl_cur, 2)); if ((j) + 3 < NT) DMA((j) + 3, ADD5(sl_cur, 3)); } \
            bias_add<DIFF>(C0, C1, bm, tab, ix); \
            if constexpr (!STAT) { rowmax_decide<DIFF, false>(C0, C1, m_reg, alC, moved, bm, tab, ix); SBAR(); } else { moved = false; } \
            _Pragma("unroll") for (int g = 0; g < NG; ++g) { \
                if (g + 2 < NG) VRD(g + 2); \
                o[g % NCB] = MFMA32(__builtin_bit_cast(bf16x8, pw[g / NCB]), PKV(vl[g % 3], vh[g % 3]), o[g % NCB]); \
                _Pragma("unroll") for (int i = 0; i < EPG; ++i) { const int e = g * EPG + i; if (e < 16) C0[e] = __builtin_amdgcn_exp2f(C0[e]); else C1[e - 16] = __builtin_amdgcn_exp2f(C1[e - 16]); } \
                if (g * EPG < 16) asm volatile("" : "+v"(C0)); else asm volatile("" : "+v"(C1)); \
                SBAR(); } \
            if (!(WB) && (j) + 1 < NT) { const LAS char* kn_ = kp0 + ADD5(sl_cur, 1) * SHM_K; kf[0] = *(const LAS bf16x8*)(kn_); kf[1] = *(const LAS bf16x8*)(kn_ + 512); } \
            if (WB) { WAIT_BAR(); } \
            if constexpr (!STAT) { RESC(alC); } ROT(); } while (0)
        for (int j = 1; j + 1 < NT; j += 2) {
            STEP(pB0, pB1, alB, pA0, pA1, alA, j, false, false);
            STEP(pA0, pA1, alA, pB0, pB1, alB, j + 1, true, true);
        }
        STEP(pB0, pB1, alB, pA0, pA1, alA, NT - 1, false, false);
        { const LAS char* vp_ = vp0 + sl_prev * SHM_V; s16x4 vl[3], vh[3];
          float s0_ = 0.f;
#pragma unroll
          for (int r = 0; r < 16; ++r) s0_ += pB0[r] + pB1[r];
          if constexpr (STAT) l_reg += s0_; else l_reg = l_reg * alB + s0_;
          pw[0] = (u32x4){PKW(pB0, 0), PKW(pB0, 2), PKW(pB0, 4), PKW(pB0, 6)}; pw[1] = (u32x4){PKW(pB0, 8), PKW(pB0, 10), PKW(pB0, 12), PKW(pB0, 14)};
          pw[2] = (u32x4){PKW(pB1, 0), PKW(pB1, 2), PKW(pB1, 4), PKW(pB1, 6)}; pw[3] = (u32x4){PKW(pB1, 8), PKW(pB1, 10), PKW(pB1, 12), PKW(pB1, 14)};
#pragma unroll
          for (int g = 0; g < NG; ++g) { if (g == 0) { VRD(0); VRD(1); } if (g + 2 < NG) VRD(g + 2); o[g % NCB] = MFMA32(__builtin_bit_cast(bf16x8, pw[g / NCB]), PKV(vl[g % 3], vh[g % 3]), o[g % NCB]); } }
#undef DMA
#undef RESC
#undef BMODE
#undef NEGM
#undef ROT
#undef ADD5
#undef STEP
#undef VRD
#undef KRD
        { auto rr = __builtin_amdgcn_permlane32_swap(__float_as_uint(l_reg), __float_as_uint(l_reg), false, false); l_reg = __uint_as_float(rr[0]) + __uint_as_float(rr[1]); }
        if (hi == 0) li_l[r32] = l_reg; asm volatile("s_waitcnt lgkmcnt(0)" ::: "memory");
        float rli[16];
#pragma unroll
        for (int r = 0; r < 16; ++r) rli[r] = __builtin_amdgcn_rcpf(li_l[crow(r, hi)]);
        bf16* mixw = (bf16*)(ws + WS_MIX) + (size_t)(sb + qw) * DM;
        if constexpr (!DIFF) {
#pragma unroll
            for (int r = 0; r < 16; ++r) { const int orow = crow(r, hi);
#pragma unroll
                for (int d0 = 0; d0 < NCB; ++d0) mixw[(size_t)orow * DM + head * 64 + d0 * 32 + r32] = (bf16)f2bf(o[d0][r] * rli[r]); }
        } else {
            if (mp == 0) {
#pragma unroll
                for (int r = 0; r < 16; ++r) { const int orow = crow(r, hi);
#pragma unroll
                    for (int d0 = 0; d0 < NCB; ++d0) mixw[(size_t)orow * DM + 512 + head * 128 + d0 * 32 + r32] = (bf16)f2bf(o[d0][r] * rli[r]); }
            } else {
                const float lam = *(const float*)(ws + WS_LAM);
                float ss[16];
#pragma unroll
                for (int r = 0; r < 16; ++r) ss[r] = 0.f;
#pragma unroll
                for (int d0 = 0; d0 < NCB; ++d0)
#pragma unroll
                    for (int r = 0; r < 16; ++r) { const float o1 = bf2f(mixw[(size_t)crow(r, hi) * DM + 512 + head * 128 + d0 * 32 + r32]);
                        const float a0 = o1 - lam * (o[d0][r] * rli[r]); o[d0][r] = a0; ss[r] += a0 * a0; }
#pragma unroll
                for (int r = 0; r < 16; ++r) {
#pragma unroll
                    for (int of = 1; of < 32; of <<= 1) ss[r] += __shfl_xor(ss[r], of);
                    ss[r] = __builtin_amdgcn_rsqf(ss[r] * (1.0f / 128.0f) + EPS) * 0.8f;
                }
                float gs[NCB];
#pragma unroll
                for (int d0 = 0; d0 < NCB; ++d0) gs[d0] = P.in[15][d0 * 32 + r32];
#pragma unroll
                for (int r = 0; r < 16; ++r) { const int orow = crow(r, hi);
#pragma unroll
                    for (int d0 = 0; d0 < NCB; ++d0) mixw[(size_t)orow * DM + 512 + head * 128 + d0 * 32 + r32] = (bf16)f2bf(o[d0][r] * ss[r] * gs[d0]); }
            }
        }
    }
}
#undef SBAR
#undef WAIT_BAR
#undef PKV
#undef PKW
#undef MFMA32
}

__device__ __forceinline__ void attn_decode(int L, int& diff, int& s, int& head, int& qb) {
    if (L < 512) { const int round = L >> 8, v = L & 255, x = v >> 5, l = v & 31; diff = 1; s = x >> 2; head = x & 3; qb = l + 32 * round; }
    else if (L < 1536) { const int Lp = L - 512, round = Lp >> 8, v = Lp & 255, x = v >> 5, l = v & 31, st = x >> 1; diff = 0; s = st >> 1; head = (st & 1) * 4 + round; qb = 32 * (x & 1) + l; }
    else if (L < 2048) { const int Lp = L - 1536, round = Lp >> 8, v = Lp & 255, x = v >> 5, l = v & 31, i = round * 32 + l; diff = 0; s = 2 + (x >> 1); head = (x & 1) * 4 + (i >> 4); qb = i & 15; }
    else { const int v = L - 2048, x = v >> 5, l = v & 31, st = 2 * x + (l >> 4); diff = 1; s = 2 + (st >> 2); head = st & 3; qb = l & 15; }
}

__device__ __forceinline__ void p0_transpose_item(const float* W, int K, int N, bf16* WT, int k0, int n0, int drow0, LAS float* scr, int lane) {
#pragma unroll 8
    for (int i = 0; i < 32; ++i) { const int kk = 2 * i + (lane >> 5); scr[kk * 33 + (lane & 31)] = W[(size_t)(k0 + kk) * N + n0 + (lane & 31)]; }
    asm volatile("s_waitcnt lgkmcnt(0)" ::: "memory");
    const int c = lane & 7;
#pragma unroll
    for (int j = 0; j < 4; ++j) { const int n = (lane >> 3) + 8 * j; const LAS float* sp = scr + (8 * c) * 33 + n;
        u32x4 o; o.x = pk2(sp[0 * 33], sp[1 * 33]); o.y = pk2(sp[2 * 33], sp[3 * 33]); o.z = pk2(sp[4 * 33], sp[5 * 33]); o.w = pk2(sp[6 * 33], sp[7 * 33]);
        *(u32x4*)(WT + (size_t)(drow0 + n) * K + k0 + 8 * c) = o; }
    asm volatile("s_waitcnt lgkmcnt(0)" ::: "memory");
}

__device__ __forceinline__ void norm_rope8(float (&v)[8], int c8, const float* g, const float* ropetab, int pos_r, int pos_c) {
    float ss = 0.f;
#pragma unroll
    for (int i = 0; i < 8; ++i) ss += v[i] * v[i];
    ss += __shfl_xor(ss, 1); ss += __shfl_xor(ss, 2); ss += __shfl_xor(ss, 4);
    const float rstd = __builtin_amdgcn_rsqf(ss * (1.0f / 64.0f) + EPS);
#pragma unroll
    for (int i = 0; i < 8; ++i) v[i] = v[i] * rstd * g[c8 * 8 + i];
    float pv[8];
#pragma unroll
    for (int i = 0; i < 8; ++i) pv[i] = __shfl_xor(v[i], 2);
    const int a = c8 >> 2, cc = c8 & 3, second = cc >> 1, i16 = (cc & 1) * 8;
    const float* tb = ropetab + ((size_t)(a ? pos_c : pos_r) * 16 + i16) * 2;
#pragma unroll
    for (int i = 0; i < 8; ++i) { const float cs = tb[2 * i], sn = tb[2 * i + 1]; v[i] = second ? (v[i] * cs + pv[i] * sn) : (v[i] * cs - pv[i] * sn); }
}
__device__ __forceinline__ void ld8bf(const bf16* p, float (&v)[8]) { const u32x4 w = *(const u32x4*)p; v[0] = bflo(w.x); v[1] = bfhi(w.x); v[2] = bflo(w.y); v[3] = bfhi(w.y); v[4] = bflo(w.z); v[5] = bfhi(w.z); v[6] = bflo(w.w); v[7] = bfhi(w.w); }
__device__ __forceinline__ u32x4 pk8(const float (&v)[8], float sc) { u32x4 w; w.x = pk2(v[0] * sc, v[1] * sc); w.y = pk2(v[2] * sc, v[3] * sc); w.z = pk2(v[4] * sc, v[5] * sc); w.w = pk2(v[6] * sc, v[7] * sc); return w; }

#define XB_TMO      128
#define XB_XCNT(j)  (256  + 64 * (j))
#define XB_XSUB(j)  (1280 + 64 * (j))
#define XB_XGEN(j)  (2304 + 64 * (j))
#define XB_TOP      3328
#define XB_TOPGEN   3392
#define XCD_BAR_WORDS 3456
#define XB_SPIN_CAP (1u << 18)
__device__ __forceinline__ unsigned xb_ld(unsigned* p)              { return __hip_atomic_load(p, __ATOMIC_RELAXED, __HIP_MEMORY_SCOPE_AGENT); }
__device__ __forceinline__ unsigned xb_add(unsigned* p, unsigned v) { return __hip_atomic_fetch_add(p, v, __ATOMIC_RELAXED, __HIP_MEMORY_SCOPE_AGENT); }
__device__ __forceinline__ unsigned xb_xcc_id() { return (unsigned)__builtin_amdgcn_s_getreg((3 << 11) | 20) & 0xFu; }
#define XB_SPIN(cond, bar) do { unsigned _sp = 0; while (cond) { __builtin_amdgcn_s_sleep(1); \
    if ((++_sp & 255u) == 0u) { if (xb_ld(&(bar)[XB_TMO])) break; if (_sp > XB_SPIN_CAP) { atomicAdd(&(bar)[XB_TMO], 1u); break; } } } } while (0)
struct XcdBarrier { unsigned* bar; unsigned x; volatile LAS unsigned* st; };
__device__ __forceinline__ XcdBarrier xcd_barrier_post(unsigned* bar, volatile LAS unsigned* st) {
    XcdBarrier b; b.bar = bar; b.x = xb_xcc_id(); b.st = st;
    if (threadIdx.x == 0) (void)xb_add(&bar[XB_XCNT(b.x)], 1u);
    return b;
}
__device__ __forceinline__ void xcd_barrier_complete(unsigned* bar, unsigned x, unsigned& nloc, unsigned& nx) {
    const unsigned G = gridDim.x * gridDim.y * gridDim.z;
    unsigned sum, cnt, mine, sp = 0u;
    for (;;) {
        sum = 0u; cnt = 0u; mine = 0u;
#pragma unroll
        for (unsigned j = 0; j < 16; ++j) { const unsigned c = xb_ld(&bar[XB_XCNT(j)]); sum += c; cnt += (c > 0u) ? 1u : 0u; mine = (j == x) ? c : mine; }
        if (sum == G) break;
        __builtin_amdgcn_s_sleep(1);
        if ((++sp & 255u) == 0u) { if (xb_ld(&bar[XB_TMO])) break; if (sp > XB_SPIN_CAP) { atomicAdd(&bar[XB_TMO], 1u); break; } }
    }
    nloc = mine > 0u ? mine : 1u; nx = cnt > 0u ? cnt : 1u;
}
__device__ __forceinline__ void xcd_barrier(const XcdBarrier& b) {
    asm volatile("s_waitcnt vmcnt(0)" ::: "memory");
    __syncthreads();
    if (threadIdx.x == 0) {
        unsigned* bar = b.bar;
        __builtin_amdgcn_s_waitcnt(0);
        unsigned nloc = b.st[0], nx = b.st[1];
        if (nloc == 0u) { xcd_barrier_complete(bar, b.x, nloc, nx); b.st[0] = nloc; b.st[1] = nx; }
        const unsigned old = xb_add(&bar[XB_XSUB(b.x)], 1u);
        const unsigned gen = old / nloc;
        if (old + 1u == (gen + 1u) * nloc) {
            __builtin_amdgcn_fence(__ATOMIC_RELEASE, "agent");
            asm volatile("s_waitcnt vmcnt(0)" ::: "memory");
            const unsigned og = xb_add(&bar[XB_TOP], 1u);
            const unsigned tg = og / nx;
            if (og + 1u == (tg + 1u) * nx) xb_add(&bar[XB_TOPGEN], 1u);
            else XB_SPIN(xb_ld(&bar[XB_TOPGEN]) == tg, bar);
            __builtin_amdgcn_fence(__ATOMIC_ACQUIRE, "agent");
            xb_add(&bar[XB_XGEN(b.x)], 1u);
            asm volatile("s_waitcnt vmcnt(0)" ::: "memory");
        } else {
            XB_SPIN(xb_ld(&bar[XB_XGEN(b.x)]) == gen, bar);
            __builtin_amdgcn_fence(__ATOMIC_ACQUIRE, "agent");
            asm volatile("s_waitcnt vmcnt(0)" ::: "memory");
        }
    }
    __syncthreads();
}

__global__ void __launch_bounds__(NWAVES * 64, 2) fwd_megakernel(Params P) {
    extern __shared__ __attribute__((aligned(16))) unsigned char lds_raw[];
    cg::grid_group grid = cg::this_grid();
    LAS unsigned char* lds = (LAS unsigned char*)lds_raw;
    const int G = gridDim.x, bx = blockIdx.x;
    const int vcu = (G % 8 == 0) ? (bx % 8) * (G / 8) + bx / 8 : bx;
    const int NGW = G * NWAVES;
#define IDS() int tid_ = threadIdx.x; asm volatile("" : "+v"(tid_)); const int tid = tid_, lane = tid & 63; const int wave = __builtin_amdgcn_readfirstlane(tid >> 6); const int gw = vcu * NWAVES + wave; (void)gw; (void)lane
    unsigned char* ws = P.ws;
    float* mod = (float*)(ws + WS_MOD);
    const float* ropetab = (const float*)(ws + WS_ROPE);
    volatile LAS unsigned* bst = (volatile LAS unsigned*)(lds + 131072);
    if (threadIdx.x < 2) bst[threadIdx.x] = 0u;
    __syncthreads();
    if (blockIdx.x == 0) { for (int i = threadIdx.x; i < (int)(BAR_ZERO_BYTES / 4); i += NWAVES * 64) ((unsigned*)(ws + WS_BAR))[i] = 0u; }

    {
        IDS();
        LAS float* scr = (LAS float*)(lds + wave * 16384);
        constexpr int I_IN = 16 * 72, I_OUT = 16 * 32, I_GU = 16 * 176, I_DN = 44 * 32, NITEMS = I_IN + I_OUT + I_GU + I_DN;
        for (int it = gw; it < NITEMS; it += NGW) {
            int r = it;
            if (r < I_IN) { const int kb = r / 72, nb = r % 72; p0_transpose_item(P.in[8], 1024, INW, (bf16*)(ws + WS_WIN), 64 * kb, 32 * nb, 32 * nb, scr, lane); continue; } r -= I_IN;
            if (r < I_OUT) { const int kb = r / 32, nb = r % 32; p0_transpose_item(P.in[16], 1024, DM, (bf16*)(ws + WS_WOUT), 64 * kb, 32 * nb, 32 * nb, scr, lane); continue; } r -= I_OUT;
            if (r < I_GU) { const int kb = r / 176, nb = r % 176; const int n0 = 32 * nb; const int j0 = n0 < DFF ? n0 : n0 - DFF;
                const int drow = (j0 >> 7) * 256 + (n0 < DFF ? 0 : 128) + (j0 & 127);
                p0_transpose_item(P.in[19], 1024, 2 * DFF, (bf16*)(ws + WS_WGU), 64 * kb, n0, drow, scr, lane); continue; } r -= I_GU;
            { const int kb = r / 32, nb = r % 32; p0_transpose_item(P.in[20], DFF, DM, (bf16*)(ws + WS_WDN), 64 * kb, 32 * nb, 32 * nb, scr, lane); }
        }
        __syncthreads();
        LAS float* sc = (LAS float*)lds;
        LAS float* part = (LAS float*)(lds + 32768);
        for (int i = tid; i < 6 * 1024; i += 512) { const int s = i >> 10, k = i & 1023; const float c = s < 2 ? P.in[2][s * 1024 + k] : P.in[3][(s - 2) * 1024 + k]; sc[i] = c / (1.0f + __expf(-c)); }
        __syncthreads();
        for (int strip = bx; strip < 256; strip += G) {
            const int cgi = tid % 6, kk = tid / 6;
            if (kk < 85) {
                f32x4 a[6];
#pragma unroll
                for (int s = 0; s < 6; ++s) a[s] = (f32x4){0.f, 0.f, 0.f, 0.f};
                for (int k = kk; k < 1024; k += 85) { const f32x4 w = *(const f32x4*)(P.in[5] + (size_t)k * 6144 + strip * 24 + cgi * 4);
#pragma unroll
                    for (int s = 0; s < 6; ++s) a[s] += w * sc[s * 1024 + k]; }
#pragma unroll
                for (int s = 0; s < 6; ++s) *(LAS f32x4*)(part + ((kk * 6 + cgi) * 6 + s) * 4) = a[s];
            }
            __syncthreads();
            if (tid < 144) { const int cgi2 = tid / 24, s = (tid / 4) % 6, e = tid & 3; float acc = 0.f;
                for (int k2 = 0; k2 < 85; ++k2) acc += part[((k2 * 6 + cgi2) * 6 + s) * 4 + e];
                const int col = strip * 24 + cgi2 * 4 + e; mod[s * 6144 + col] = acc + P.in[6][col]; }
            __syncthreads();
        }
        { const int gt = bx * 512 + tid; if (gt < 4096) { const int pos = gt >> 4, i = gt & 15; const float inv = powf(10000.0f, -(float)i / 16.0f); const float ang = (float)pos * inv;
            float sn, cs; sincosf(ang, &sn, &cs); ((float*)(ws + WS_ROPE))[gt * 2] = cs; ((float*)(ws + WS_ROPE))[gt * 2 + 1] = sn; } }
        if (bx == 0 && wave == 0) { const float a = wave_sum(P.in[11][lane] * P.in[12][lane]), b = wave_sum(P.in[13][lane] * P.in[14][lane]);
            if (lane == 0) *(float*)(ws + WS_LAM) = expf(a) - expf(b) + 0.2f;
            float gq = fabsf(P.in[9][lane]), gk = fabsf(P.in[10][lane]);
#pragma unroll
            for (int o = 1; o < 64; o <<= 1) { gq = fmaxf(gq, __shfl_xor(gq, o)); gk = fmaxf(gk, __shfl_xor(gk, o)); }
            if (lane == 0) *(float*)(ws + WS_LAM + 4) = 64.0f * QSCALE * gq * gk * 1.02f + 0.1f; }
    }
    grid.sync();
    const XcdBarrier xbar = xcd_barrier_post((unsigned*)(ws + WS_BAR), bst);

    { IDS();
    for (int m0 = gw * 4; m0 < NTOK; m0 += NGW * 4) {
        const int s = seq_of_row(m0); const float* md = mod + s * 6144;
        f32x4 v[4][4]; float ss[4];
#pragma unroll
        for (int r = 0; r < 4; ++r) { const float* xr = x_row(P, m0 + r); ss[r] = 0.f;
#pragma unroll
            for (int j = 0; j < 4; ++j) v[r][j] = *(const f32x4*)(xr + 4 * lane + 256 * j); }
#pragma unroll
        for (int r = 0; r < 4; ++r)
#pragma unroll
            for (int j = 0; j < 4; ++j) ss[r] += (v[r][j].x * v[r][j].x + v[r][j].y * v[r][j].y) + (v[r][j].z * v[r][j].z + v[r][j].w * v[r][j].w);
        wave_sum4(ss);
#pragma unroll
        for (int r = 0; r < 4; ++r) ss[r] = __builtin_amdgcn_rsqf(ss[r] * (1.0f / DM) + EPS);
#pragma unroll
        for (int j = 0; j < 4; ++j) { const int c = 4 * lane + 256 * j; const f32x4 g = *(const f32x4*)(P.in[7] + c), sh = *(const f32x4*)(md + c), scl = *(const f32x4*)(md + 1024 + c);
            const f32x4 gg = g * (scl + 1.0f);
#pragma unroll
            for (int r = 0; r < 4; ++r) { const f32x4 y = v[r][j] * ss[r] * gg + sh; u32x2 w; w.x = pk2(y.x, y.y); w.y = pk2(y.z, y.w); *(u32x2*)((bf16*)(ws + WS_H) + (size_t)(m0 + r) * DM + c) = w; } }
    } }
    xcd_barrier(xbar);

    { pg8::Gemm g{(const bf16*)(ws + WS_H), (const bf16*)(ws + WS_WIN), NTOK, INW, DM}; pg8::StaticOrder S; S.init(NTOK, INW, G, bx);
      EpiProj E{(bf16*)(ws + WS_PROJ), INW, ws};
      pg8::gemm_phase<EpiProj, pg8::StaticOrder, true, true>(lds, g, S, E); }
    xcd_barrier(xbar);

    { IDS();
    for (int m0 = gw * 4; m0 < NTOK; m0 += NGW * 4) {
        const int s = seq_of_row(m0), sb = seq_base(s), n = seq_len(s);
        const bf16* pr = (const bf16*)(ws + WS_PROJ) + (size_t)m0 * INW;
        const int c8 = lane & 7, hh = lane >> 3, rk = lane >> 4, l4 = lane & 15;
        u32x4 wq[4];
#pragma unroll
        for (int r = 0; r < 4; ++r) wq[r] = *(const u32x4*)(pr + (size_t)r * INW + lane * 8);
        const u32x4 wk = *(const u32x4*)(pr + (size_t)rk * INW + 512 + l4 * 8);
#pragma unroll
        for (int r = 0; r < 4; ++r) { const int t = m0 + r - sb, tile = t >> 6, key = t & 63;
            float v[8] = {bflo(wq[r].x), bfhi(wq[r].x), bflo(wq[r].y), bfhi(wq[r].y), bflo(wq[r].z), bfhi(wq[r].z), bflo(wq[r].w), bfhi(wq[r].w)};
            norm_rope8(v, c8, P.in[9], ropetab, tile, key);
            *(u32x4*)(ws + WS_QG + ((size_t)sb * 8 + (size_t)hh * n + t) * 128 + c8 * 16) = pk8(v, QSCALE); }
        { const int t = m0 + rk - sb, tile = t >> 6, key = t & 63, kvh = l4 >> 3;
          float v[8] = {bflo(wk.x), bfhi(wk.x), bflo(wk.y), bfhi(wk.y), bflo(wk.z), bfhi(wk.z), bflo(wk.w), bfhi(wk.w)};
          norm_rope8(v, c8, P.in[10], ropetab, tile, key);
          *(u32x4*)(ws + WS_KG + ((size_t)sb * 2 + (size_t)kvh * n) * 128 + (size_t)tile * 8192 + k_img(key, c8 * 8)) = pk8(v, 1.0f); }
    }
    { unsigned* kq = (unsigned*)(ws + WS_BAR) + 3800;
      for (int g = gw; g < 2 * 6144; g += NGW) {
          const int isq = g >= 6144 ? 1 : 0, gt = isq ? g - 6144 : g;
          const int R = gt * 64, s = seq_of_row(R >> 3), sb = seq_base(s), n = seq_len(s), hh = (R - sb * 8) / n;
          const unsigned char* base = ws + (isq ? WS_QD : WS_KD) + (size_t)gt * 8192;
          float ss = 0.f;
#pragma unroll
          for (int i = 0; i < 8; ++i) { const u32x4 w = *(const u32x4*)(base + (isq ? lane * 128 + i * 16 : i * 1024 + lane * 16));
              const float f0 = bflo(w.x), f1 = bfhi(w.x), f2 = bflo(w.y), f3 = bfhi(w.y), f4 = bflo(w.z), f5 = bfhi(w.z), f6 = bflo(w.w), f7 = bfhi(w.w);
              ss += (f0 * f0 + f1 * f1) + (f2 * f2 + f3 * f3) + (f4 * f4 + f5 * f5) + (f6 * f6 + f7 * f7); }
#pragma unroll
          for (int o = 1; o < 64; o <<= 1) ss = fmaxf(ss, __shfl_xor(ss, o));
          if (lane == 0) atomicMax(kq + isq * 48 + s * 8 + hh, __float_as_uint(ss));
      } }
    }
    xcd_barrier(xbar);

    for (int L = vcu; L < 2304; L += G) {
        int diff, s, head, qb; attn_decode(L, diff, s, head, qb);
        const float sref = *(const float*)(ws + WS_LAM + 4);
        if (diff) {
            const unsigned* kq = (const unsigned*)(ws + WS_BAR) + 3800;
            float bmx = -3.0e38f, bmn = 3.0e38f;
            for (int b = 0; b < 32; ++b) { const float v = P.in[4][b * 4 + head] * LOG2E; bmx = fmaxf(bmx, v); bmn = fminf(bmn, v); }
            const int si = s * 8 + head * 2;
            const float qk0 = __builtin_sqrtf(__uint_as_float(kq[si]) * __uint_as_float(kq[48 + si])), qk1 = __builtin_sqrtf(__uint_as_float(kq[si + 1]) * __uint_as_float(kq[48 + si + 1]));
            if (2.0f * fmaxf(qk0, qk1) + (bmx - bmn) <= 100.0f) att2::attn_unit<4, true, true>((LAS char*)lds, P, s, head, qb, bmx);
            else att2::attn_unit<4, true, false>((LAS char*)lds, P, s, head, qb, 0.f);
        }
        else if (sref <= 40.0f) att2::attn_unit<2, false, true>((LAS char*)lds, P, s, head, qb, sref);
        else att2::attn_unit<2, false, false>((LAS char*)lds, P, s, head, qb, 0.f);
    }
    xcd_barrier(xbar);

    { pg8::Gemm g{(const bf16*)(ws + WS_MIX), (const bf16*)(ws + WS_WOUT), NTOK, DM, DM}; pg8::StaticOrder S; S.init(NTOK, DM, G, bx);
      pg8::EpiBf16 E{(bf16*)(ws + WS_O), DM};
      pg8::gemm_phase<pg8::EpiBf16, pg8::StaticOrder, true, true>(lds, g, S, E); }
    xcd_barrier(xbar);

    { IDS();
    for (int m0 = gw * 4; m0 < NTOK; m0 += NGW * 4) {
        const int s = seq_of_row(m0); const float* md = mod + s * 6144;
        f32x4 ov[4][4], xv[4][4]; float ss[4];
#pragma unroll
        for (int r = 0; r < 4; ++r) { const bf16* orow = (const bf16*)(ws + WS_O) + (size_t)(m0 + r) * DM; const float* xr = x_row(P, m0 + r); ss[r] = 0.f;
#pragma unroll
            for (int j = 0; j < 4; ++j) { const u32x2 w = *(const u32x2*)(orow + 4 * lane + 256 * j); ov[r][j] = (f32x4){bflo(w.x), bfhi(w.x), bflo(w.y), bfhi(w.y)}; xv[r][j] = *(const f32x4*)(xr + 4 * lane + 256 * j); } }
#pragma unroll
        for (int r = 0; r < 4; ++r)
#pragma unroll
            for (int j = 0; j < 4; ++j) ss[r] += (ov[r][j].x * ov[r][j].x + ov[r][j].y * ov[r][j].y) + (ov[r][j].z * ov[r][j].z + ov[r][j].w * ov[r][j].w);
        wave_sum4(ss);
        float s1[4];
#pragma unroll
        for (int r = 0; r < 4; ++r) { ss[r] = __builtin_amdgcn_rsqf(ss[r] * (1.0f / DM) + EPS); s1[r] = 0.f; }
#pragma unroll
        for (int j = 0; j < 4; ++j) { const int c = 4 * lane + 256 * j; const f32x4 g = *(const f32x4*)(P.in[17] + c), gt = *(const f32x4*)(md + 2048 + c); const f32x4 gg = g * gt;
#pragma unroll
            for (int r = 0; r < 4; ++r) { const f32x4 x1 = xv[r][j] + gg * (ov[r][j] * ss[r]); xv[r][j] = x1; s1[r] += (x1.x * x1.x + x1.y * x1.y) + (x1.z * x1.z + x1.w * x1.w);
                *(f32x4*)(P.out + (size_t)(m0 + r) * DM + c) = x1; } }
        wave_sum4(s1);
#pragma unroll
        for (int r = 0; r < 4; ++r) s1[r] = __builtin_amdgcn_rsqf(s1[r] * (1.0f / DM) + EPS);
#pragma unroll
        for (int j = 0; j < 4; ++j) { const int c = 4 * lane + 256 * j; const f32x4 g = *(const f32x4*)(P.in[18] + c), sh = *(const f32x4*)(md + 3072 + c), scl = *(const f32x4*)(md + 4096 + c); const f32x4 gg = g * (scl + 1.0f);
#pragma unroll
            for (int r = 0; r < 4; ++r) { const f32x4 y = xv[r][j] * s1[r] * gg + sh; u32x2 w; w.x = pk2(y.x, y.y); w.y = pk2(y.z, y.w); *(u32x2*)((bf16*)(ws + WS_H2) + (size_t)(m0 + r) * DM + c) = w; } }
    } }
    xcd_barrier(xbar);

    { pg8::Gemm g{(const bf16*)(ws + WS_H2), (const bf16*)(ws + WS_WGU), NTOK, 2 * DFF, DM}; pg8::StaticOrder S; S.init(NTOK, 2 * DFF, G, bx);
      pg8::EpiSwiGLU E{(bf16*)(ws + WS_ACT), DFF};
      pg8::gemm_phase<pg8::EpiSwiGLU, pg8::StaticOrder, true, true>(lds, g, S, E); }
    xcd_barrier(xbar);

    { pg8::Gemm g{(const bf16*)(ws + WS_ACT), (const bf16*)(ws + WS_WDN), NTOK, DM, DFF}; pg8::StaticOrder S; S.init(NTOK, DM, G, bx);
      pg8::EpiBf16 E{(bf16*)(ws + WS_F), DM};
      pg8::gemm_phase<pg8::EpiBf16, pg8::StaticOrder, true, true>(lds, g, S, E); }
    xcd_barrier(xbar);

    { IDS();
    for (int m0 = gw * 4; m0 < NTOK; m0 += NGW * 4) {
        const int s = seq_of_row(m0); const float* md = mod + s * 6144;
        f32x4 fv[4][4], xv[4][4]; float ss[4];
#pragma unroll
        for (int r = 0; r < 4; ++r) { const bf16* frow = (const bf16*)(ws + WS_F) + (size_t)(m0 + r) * DM; const float* xr = P.out + (size_t)(m0 + r) * DM; ss[r] = 0.f;
#pragma unroll
            for (int j = 0; j < 4; ++j) { const u32x2 w = *(const u32x2*)(frow + 4 * lane + 256 * j); fv[r][j] = (f32x4){bflo(w.x), bfhi(w.x), bflo(w.y), bfhi(w.y)}; xv[r][j] = *(const f32x4*)(xr + 4 * lane + 256 * j); } }
#pragma unroll
        for (int r = 0; r < 4; ++r)
#pragma unroll
            for (int j = 0; j < 4; ++j) ss[r] += (fv[r][j].x * fv[r][j].x + fv[r][j].y * fv[r][j].y) + (fv[r][j].z * fv[r][j].z + fv[r][j].w * fv[r][j].w);
        wave_sum4(ss);
#pragma unroll
        for (int r = 0; r < 4; ++r) ss[r] = __builtin_amdgcn_rsqf(ss[r] * (1.0f / DM) + EPS);
#pragma unroll
        for (int j = 0; j < 4; ++j) { const int c = 4 * lane + 256 * j; const f32x4 g = *(const f32x4*)(P.in[21] + c), gt = *(const f32x4*)(md + 5120 + c); const f32x4 gg = g * gt;
#pragma unroll
            for (int r = 0; r < 4; ++r) *(f32x4*)(P.out + (size_t)(m0 + r) * DM + c) = xv[r][j] + gg * (fv[r][j] * ss[r]); }
    } }
}

extern "C" void kernel_launch(void* const* d_in, const int* in_sizes, int n_in, void* d_out, int out_size, void* d_ws, size_t ws_size, hipStream_t stream) {
    static int grid_blocks = 0;
    if (grid_blocks == 0) {
        if (n_in != 22 || out_size != NTOK * DM || ws_size < WS_END) { fprintf(stderr, "kernel_launch: unexpected shapes (n_in %d out %d ws %zu)\n", n_in, out_size, ws_size); grid_blocks = -1; return; }
        int dev = 0, cus = 0, per_cu = 0;
        if (hipGetDevice(&dev) != hipSuccess || hipDeviceGetAttribute(&cus, hipDeviceAttributeMultiprocessorCount, dev) != hipSuccess) { grid_blocks = -1; return; }
        if (hipFuncSetAttribute((const void*)fwd_megakernel, hipFuncAttributeMaxDynamicSharedMemorySize, LDS_BYTES) != hipSuccess) { fprintf(stderr, "kernel_launch: hipFuncSetAttribute failed\n"); grid_blocks = -1; return; }
        if (hipOccupancyMaxActiveBlocksPerMultiprocessor(&per_cu, (const void*)fwd_megakernel, NWAVES * 64, LDS_BYTES) != hipSuccess || per_cu < 1) { fprintf(stderr, "kernel_launch: occupancy query failed (%d)\n", per_cu); per_cu = 1; }
        (void)hipGetLastError();
        grid_blocks = cus * per_cu;
    }
    if (grid_blocks < 0) return;
    Params p{};
    for (int i = 0; i < 22; ++i) p.in[i] = (const float*)d_in[i];
    p.out = (float*)d_out; p.ws = (unsigned char*)d_ws;
    void* args[] = {&p};
    hipError_t e = hipLaunchCooperativeKernel((const void*)fwd_megakernel, dim3(grid_blocks), dim3(NWAVES * 64), args, LDS_BYTES, stream);
    if (e != hipSuccess) fprintf(stderr, "cooperative launch failed: %s (grid %d)\n", hipGetErrorString(e), grid_blocks);
}
```

```cpp
#include <hip/hip_runtime.h>
#include <hip/hip_cooperative_groups.h>
#include <cstdio>
#include <cstdint>
namespace cg = cooperative_groups;

namespace pg8 {
#define PG8_LAS __attribute__((address_space(3)))
typedef unsigned short bf16_t;
typedef short bf16x8 __attribute__((ext_vector_type(8)));
typedef float f32x4 __attribute__((ext_vector_type(4)));
typedef unsigned u32x4 __attribute__((ext_vector_type(4)));
constexpr int BM = 256, BK = 64, HALF = 128, HTB = HALF * BK * 2, STAGE_BYTES = 8 * HTB, NXCD = 8, WGM = 8;

__host__ __device__ __forceinline__ int lds_byte(int r, int c) { const int st = (r >> 4) * 2 + (c >> 5), rr = r & 15, cc = c & 31, ob = rr * 64 + cc * 2; return st * 1024 + (ob ^ (((ob >> 9) & 1) << 5)); }
__host__ __device__ __forceinline__ void stage_rc(int b, int& R, int& C) { const int st = b / 1024, sb = b % 1024, swz = sb ^ (((sb >> 9) & 1) << 5); R = (st >> 1) * 16 + swz / 64; C = (st & 1) * 32 + (swz % 64) / 2; }
__host__ __device__ __forceinline__ int perm32(int rho) { const int n = rho >> 4, i = rho & 15; return 8 * (i >> 2) + 4 * n + (i & 3); }

struct Unit { int pm, pn; };
struct Gemm { const bf16_t* A; const bf16_t* Bt; int M, N, K; };

struct StaticOrder {
    int nM, nN, nwg, G, c;
    __host__ __device__ void init(int M, int N, int G_, int c_) { nM = M / BM; nN = N / BM; nwg = nM * nN; G = G_; c = c_; }
    __host__ __device__ bool next(int i, Unit& u) const {
        const long L = (long)i * G + c; if (L >= nwg) return false;
        int wgid = (int)L; { const int q = nwg / NXCD, r = nwg % NXCD, xcd = wgid % NXCD, off = wgid / NXCD; wgid = (xcd < r ? xcd * (q + 1) : r * (q + 1) + (xcd - r) * q) + off; }
        const int nig = WGM * nN, gid = wgid / nig, fm = gid * WGM, gsz = (nM - fm) < WGM ? (nM - fm) : WGM;
        u.pm = fm + ((wgid % nig) % gsz); u.pn = (wgid % nig) / gsz; return true;
    }
    __device__ __forceinline__ void a_ready(const Unit&) const {}
    __device__ __forceinline__ void done(const Unit&) const {}
};

__device__ __forceinline__ unsigned cvt_pk_bf16(float lo, float hi) { unsigned r; asm volatile("v_cvt_pk_bf16_f32 %0, %1, %2" : "=v"(r) : "v"(lo), "v"(hi)); return r; }

struct EpiBf16 {
    static constexpr bool PERM = true, AFTER_DRAIN = false;
    bf16_t* O; int ldc;
    __device__ __forceinline__ void operator()(const f32x4 (&acc)[2][2][4][2], const Unit& u, int wr, int wc, int fr, int fq) const {
        const int row0 = u.pm * BM + wr * 64 + fr; const int col0 = u.pn * BM + wc * 32 + 8 * fq;
#pragma unroll
        for (int ai = 0; ai < 2; ++ai)
#pragma unroll
            for (int m = 0; m < 4; ++m) { bf16_t* rowp = O + (size_t)(row0 + ai * HALF + m * 16) * ldc + col0;
#pragma unroll
                for (int bj = 0; bj < 2; ++bj) { const f32x4 v0 = acc[ai][bj][m][0], v1 = acc[ai][bj][m][1];
                    u32x4 w; w.x = cvt_pk_bf16(v0[0], v0[1]); w.y = cvt_pk_bf16(v0[2], v0[3]); w.z = cvt_pk_bf16(v1[0], v1[1]); w.w = cvt_pk_bf16(v1[2], v1[3]);
                    *(u32x4*)(rowp + bj * HALF) = w; } }
    }
};
__device__ __forceinline__ float silu_mul(float g, float u) { const float e = __builtin_amdgcn_exp2f(-1.4426950408889634f * g); return g * __builtin_amdgcn_rcpf(1.0f + e) * u; }
struct EpiSwiGLU {
    static constexpr bool PERM = true, AFTER_DRAIN = false;
    bf16_t* O; int ldc;
    __device__ __forceinline__ void operator()(const f32x4 (&acc)[2][2][4][2], const Unit& u, int wr, int wc, int fr, int fq) const {
        const int row0 = u.pm * BM + wr * 64 + fr; const int col0 = u.pn * HALF + wc * 32 + 8 * fq;
#pragma unroll
        for (int ai = 0; ai < 2; ++ai)
#pragma unroll
            for (int m = 0; m < 4; ++m) { bf16_t* rowp = O + (size_t)(row0 + ai * HALF + m * 16) * ldc + col0;
                const f32x4 g0 = acc[ai][0][m][0], g1 = acc[ai][0][m][1], u0 = acc[ai][1][m][0], u1 = acc[ai][1][m][1];
                u32x4 w; w.x = cvt_pk_bf16(silu_mul(g0[0], u0[0]), silu_mul(g0[1], u0[1])); w.y = cvt_pk_bf16(silu_mul(g0[2], u0[2]), silu_mul(g0[3], u0[3]));
                w.z = cvt_pk_bf16(silu_mul(g1[0], u1[0]), silu_mul(g1[1], u1[1])); w.w = cvt_pk_bf16(silu_mul(g1[2], u1[2]), silu_mul(g1[3], u1[3]));
                *(u32x4*)rowp = w; }
    }
};

template <class Epi, class Sched, bool ALIGN_EPI = false, bool SP2 = false>
__device__ __forceinline__ void gemm_phase(PG8_LAS unsigned char* lds, const Gemm g, const Sched& S, const Epi& E) {
    int tid_ = threadIdx.x; asm volatile("" : "+v"(tid_));
    const int tid = tid_, wid = __builtin_amdgcn_readfirstlane(tid >> 6), lane = tid & 63, wr = wid >> 2, wc = wid & 3, fr = lane & 15, fq = lane >> 4;
    const int K = g.K, nt = K / BK;
    unsigned voffA[2], voffB[2];
#pragma unroll
    for (int i = 0; i < 2; ++i) { int R, C; stage_rc(tid * 16 + i * 8192, R, C); const int Rb = Epi::PERM ? ((R & ~31) + perm32(R & 31)) : R;
        voffA[i] = (unsigned)(R * K + C) * 2u; voffB[i] = (unsigned)(Rb * K + C) * 2u; }
    const size_t kstep = (size_t)(BK * 2);
    const size_t hstep = (size_t)HALF * K * 2;
    const size_t tstep = 2 * hstep;
    const unsigned ldsw = (unsigned)wid * 1024u;
    const int aoff = lds_byte(wr * 64 + fr, fq * 8), boff = lds_byte(wc * 32 + fr, fq * 8);
#define PG8_SA(b, h) (((b) * 2 + (h)) * HTB)
#define PG8_SB(b, h) ((4 + (b) * 2 + (h)) * HTB)
#define PG8_STAGE(bufoff, gbase, voff) do { _Pragma("unroll") for (int _i = 0; _i < 2; ++_i) \
        __builtin_amdgcn_global_load_lds((const unsigned*)((const char*)(gbase) + (voff)[_i]), (PG8_LAS unsigned*)(lds + (bufoff) + ldsw + _i * 8192), 16, 0, 0); } while (0)
#define PG8_LDA(dst, b, h) do { _Pragma("unroll") for (int m = 0; m < 4; ++m) _Pragma("unroll") for (int k = 0; k < 2; ++k) dst[m][k] = *(const PG8_LAS bf16x8*)(lds + PG8_SA(b, h) + aoff + m * 2048 + k * 1024); } while (0)
#define PG8_LDB(dst, b, h) do { _Pragma("unroll") for (int n = 0; n < 2; ++n) _Pragma("unroll") for (int k = 0; k < 2; ++k) dst[n][k] = *(const PG8_LAS bf16x8*)(lds + PG8_SB(b, h) + boff + n * 2048 + k * 1024); } while (0)
#define PG8_MMA(ai, bj, At, Bt) do { __builtin_amdgcn_s_setprio(1); _Pragma("unroll") for (int m = 0; m < 4; ++m) _Pragma("unroll") for (int n = 0; n < 2; ++n) _Pragma("unroll") for (int k = 0; k < 2; ++k) \
        acc[ai][bj][m][n] = __builtin_amdgcn_mfma_f32_16x16x32_bf16(Bt[n][k], At[m][k], acc[ai][bj][m][n], 0, 0, 0); __builtin_amdgcn_s_setprio(0); } while (0)
#define PG8_WAIT_V(n) asm volatile("s_waitcnt vmcnt(" #n ")" ::: "memory")
#define PG8_WAIT_L(n) asm volatile("s_waitcnt lgkmcnt(" #n ")" ::: "memory")
#define PG8_BAR __builtin_amdgcn_s_barrier()
#define PG8_SCHED __builtin_amdgcn_sched_barrier(0)
    Unit cur, nxt; int ui = 0;
    if (!S.next(0, cur)) return;
    f32x4 acc[2][2][4][2];
#pragma unroll
    for (int a = 0; a < 2; ++a)
#pragma unroll
        for (int b = 0; b < 2; ++b)
#pragma unroll
            for (int m = 0; m < 4; ++m)
#pragma unroll
                for (int n = 0; n < 2; ++n) acc[a][b][m][n] = (f32x4){0.f, 0.f, 0.f, 0.f};
    bf16x8 At[4][2], B0[2][2], B1[2][2];
    const char* cA = (const char*)g.A + (size_t)cur.pm * tstep; const char* cB = (const char*)g.Bt + (size_t)cur.pn * tstep;
    S.a_ready(cur);
    if constexpr (SP2) {
        PG8_STAGE(PG8_SB(0, 0), cB, voffB); PG8_STAGE(PG8_SB(0, 1), cB + hstep, voffB); PG8_STAGE(PG8_SA(0, 0), cA, voffA); PG8_STAGE(PG8_SA(0, 1), cA + hstep, voffA);
        if (wr == 1) PG8_BAR;
        PG8_WAIT_V(2); PG8_BAR;
        PG8_STAGE(PG8_SB(1, 0), cB + kstep, voffB); PG8_STAGE(PG8_SA(1, 0), cA + kstep, voffA); PG8_STAGE(PG8_SB(1, 1), cB + hstep + kstep, voffB);
        PG8_WAIT_V(6); PG8_BAR;
    } else {
        PG8_STAGE(PG8_SB(0, 0), cB, voffB); PG8_STAGE(PG8_SA(0, 0), cA, voffA); PG8_STAGE(PG8_SB(0, 1), cB + hstep, voffB); PG8_STAGE(PG8_SA(0, 1), cA + hstep, voffA);
        if (wr == 1) PG8_BAR;
        PG8_WAIT_V(4); PG8_BAR;
        PG8_STAGE(PG8_SB(1, 0), cB + kstep, voffB); PG8_STAGE(PG8_SA(1, 0), cA + kstep, voffA); PG8_STAGE(PG8_SB(1, 1), cB + hstep + kstep, voffB);
        PG8_WAIT_V(6); PG8_BAR;
    }
    for (;;) {
        const bool has_next = S.next(ui + 1, nxt);
        const char* nA = has_next ? (const char*)g.A + (size_t)nxt.pm * tstep : cA; const char* nB = has_next ? (const char*)g.Bt + (size_t)nxt.pn * tstep : cB;
        for (int t = 0; t < nt; t += 2) {
            const bool last = (t == nt - 2);
            const char* a1 = cA + (size_t)(t + 1) * kstep;
            const char* a2 = last ? nA : cA + (size_t)(t + 2) * kstep; const char* b2 = last ? nB : cB + (size_t)(t + 2) * kstep;
            const char* a3 = a2 + kstep; const char* b3 = b2 + kstep;
            if (last && has_next) S.a_ready(nxt);
            if constexpr (SP2) {
            PG8_LDB(B0, 0, 0); PG8_LDB(B1, 0, 1); PG8_SCHED; PG8_LDA(At, 0, 0); PG8_STAGE(PG8_SA(1, 1), a1 + hstep, voffA);
            PG8_WAIT_V(8); PG8_WAIT_L(0); PG8_BAR; PG8_MMA(0, 0, At, B0); PG8_MMA(0, 1, At, B1); PG8_BAR; PG8_SCHED;
            PG8_LDA(At, 0, 1); PG8_STAGE(PG8_SB(0, 0), b2, voffB); PG8_STAGE(PG8_SB(0, 1), b2 + hstep, voffB); PG8_STAGE(PG8_SA(0, 0), a2, voffA);
            PG8_WAIT_V(8); PG8_WAIT_L(0); PG8_BAR; PG8_MMA(1, 0, At, B0); PG8_MMA(1, 1, At, B1); PG8_BAR; PG8_SCHED;
            PG8_LDB(B0, 1, 0); PG8_LDB(B1, 1, 1); PG8_SCHED; PG8_LDA(At, 1, 0); PG8_STAGE(PG8_SA(0, 1), a2 + hstep, voffA);
            PG8_WAIT_V(8); PG8_WAIT_L(0); PG8_BAR; PG8_MMA(0, 0, At, B0); PG8_MMA(0, 1, At, B1); PG8_BAR; PG8_SCHED;
            PG8_LDA(At, 1, 1); PG8_STAGE(PG8_SB(1, 0), b3, voffB); PG8_STAGE(PG8_SB(1, 1), b3 + hstep, voffB); PG8_STAGE(PG8_SA(1, 0), a3, voffA);
            PG8_WAIT_V(8); PG8_WAIT_L(0); PG8_BAR; PG8_MMA(1, 0, At, B0); PG8_MMA(1, 1, At, B1); PG8_BAR; PG8_SCHED;
            } else {
            PG8_LDB(B0, 0, 0); PG8_SCHED; PG8_LDA(At, 0, 0); PG8_STAGE(PG8_SA(1, 1), a1 + hstep, voffA);
            PG8_WAIT_L(8); PG8_BAR; PG8_WAIT_L(0); PG8_MMA(0, 0, At, B0); PG8_BAR; PG8_SCHED;
            PG8_LDB(B1, 0, 1); PG8_STAGE(PG8_SB(0, 0), b2, voffB);
            PG8_BAR; PG8_WAIT_L(0); PG8_MMA(0, 1, At, B1); PG8_BAR;
            PG8_LDA(At, 0, 1); PG8_STAGE(PG8_SA(0, 0), a2, voffA);
            PG8_BAR; PG8_WAIT_L(0); PG8_MMA(1, 0, At, B0); PG8_BAR; PG8_SCHED;
            PG8_STAGE(PG8_SB(0, 1), b2 + hstep, voffB);
            PG8_WAIT_V(6); PG8_BAR; PG8_MMA(1, 1, At, B1); PG8_BAR;
            PG8_LDB(B0, 1, 0); PG8_SCHED; PG8_LDA(At, 1, 0); PG8_STAGE(PG8_SA(0, 1), a2 + hstep, voffA);
            PG8_WAIT_L(8); PG8_BAR; PG8_WAIT_L(0); PG8_MMA(0, 0, At, B0); PG8_BAR; PG8_SCHED;
            PG8_LDB(B1, 1, 1); PG8_STAGE(PG8_SB(1, 0), b3, voffB);
            PG8_BAR; PG8_WAIT_L(0); PG8_MMA(0, 1, At, B1); PG8_BAR;
            PG8_LDA(At, 1, 1); PG8_STAGE(PG8_SA(1, 0), a3, voffA);
            PG8_BAR; PG8_WAIT_L(0); PG8_MMA(1, 0, At, B0); PG8_BAR; PG8_SCHED;
            PG8_STAGE(PG8_SB(1, 1), b3 + hstep, voffB);
            PG8_WAIT_V(6); PG8_BAR; PG8_MMA(1, 1, At, B1); PG8_BAR;
            }
        }
        if constexpr (ALIGN_EPI) { if (wr == 0) PG8_BAR; }
        if constexpr (!Epi::AFTER_DRAIN) { E(acc, cur, wr, wc, fr, fq); S.done(cur); }
        if (!has_next) break;
#pragma unroll
        for (int a = 0; a < 2; ++a)
#pragma unroll
            for (int b = 0; b < 2; ++b)
#pragma unroll
                for (int m = 0; m < 4; ++m)
#pragma unroll
                    for (int n = 0; n < 2; ++n) acc[a][b][m][n] = (f32x4){0.f, 0.f, 0.f, 0.f};
        cur = nxt; cA = nA; cB = nB; ++ui;
        if constexpr (ALIGN_EPI) { if (wr == 1) PG8_BAR; }
    }
    PG8_WAIT_V(0);
    if constexpr (!ALIGN_EPI) { if (wr == 0) PG8_BAR; }
    PG8_BAR;
#undef PG8_SA
#undef PG8_SB
#undef PG8_STAGE
#undef PG8_LDA
#undef PG8_LDB
#undef PG8_MMA
#undef PG8_WAIT_V
#undef PG8_WAIT_L
#undef PG8_BAR
#undef PG8_SCHED
}
}

#define LAS __attribute__((address_space(3)))
typedef unsigned short bf16;
typedef short bf16x8 __attribute__((ext_vector_type(8)));
typedef short s16x4 __attribute__((ext_vector_type(4)));
typedef float f32x16 __attribute__((ext_vector_type(16)));
typedef float f32x4 __attribute__((ext_vector_type(4)));
typedef unsigned u32x4 __attribute__((ext_vector_type(4)));
typedef unsigned u32x2 __attribute__((ext_vector_type(2)));

constexpr int DM = 1024, INW = 2304, DFF = 2816, NTOK = 49152, NWAVES = 8;
constexpr float EPS = 1e-6f, LOG2E = 1.4426950408889634f, QSCALE = 0.125f * 1.4426950408889634f;
constexpr size_t MiB = 1u << 20;
constexpr size_t WS_MOD = 0, WS_LAM = 160 * 1024, WS_ROPE = 192 * 1024, WS_BAR = 512 * 1024, BAR_ZERO_BYTES = 16384;
constexpr size_t WS_WIN = 1 * MiB, WS_WOUT = 6 * MiB, WS_WGU = 8 * MiB, WS_WDN = 19 * MiB;
constexpr size_t WS_R1 = 25 * MiB;
constexpr size_t WS_RA = 121 * MiB;
constexpr size_t WS_RB = 337 * MiB;
constexpr size_t WS_END = 493 * MiB;
constexpr size_t WS_QG = WS_R1, WS_KG = WS_R1 + 48 * MiB, WS_VG = 481 * MiB;
constexpr size_t WS_QD = WS_RB, WS_KD = WS_RB + 48 * MiB, WS_VD = WS_RB + 96 * MiB;
constexpr size_t WS_H = WS_R1, WS_PROJ = WS_RA, WS_MIX = WS_RA, WS_O = WS_RA + 96 * MiB, WS_H2 = WS_R1, WS_ACT = WS_RA, WS_F = WS_R1;

constexpr int LDS_BYTES = 131072 + 1024;

struct Params {
    const float* in[22]; float* out; unsigned char* ws;
};

__device__ __forceinline__ int seq_of_row(int m) { return m < 32768 ? (m >> 14) : 2 + ((m - 32768) >> 12); }
__device__ __forceinline__ int seq_base(int s) { return s < 2 ? s * 16384 : 32768 + (s - 2) * 4096; }
__device__ __forceinline__ int seq_len(int s) { return s < 2 ? 16384 : 4096; }
__device__ __forceinline__ const float* x_row(const Params& P, int m) { return m < 32768 ? P.in[0] + (size_t)m * DM : P.in[1] + (size_t)(m - 32768) * DM; }

__device__ __forceinline__ unsigned f2bf(float f) { unsigned u = __builtin_bit_cast(unsigned, f); return (u + 0x7fffu + ((u >> 16) & 1u)) >> 16; }
__device__ __forceinline__ unsigned pk2(float lo, float hi) { return f2bf(lo) | (f2bf(hi) << 16); }
__device__ __forceinline__ float bf2f(unsigned short b) { return __builtin_bit_cast(float, (unsigned)b << 16); }
__device__ __forceinline__ float bflo(unsigned w) { return __builtin_bit_cast(float, w << 16); }
__device__ __forceinline__ float bfhi(unsigned w) { return __builtin_bit_cast(float, w & 0xffff0000u); }
__device__ __forceinline__ float wave_sum(float v) {
#pragma unroll
    for (int o = 1; o < 64; o <<= 1) v += __shfl_xor(v, o);
    return v;
}
__device__ __forceinline__ void wave_sum4(float (&v)[4]) {
#pragma unroll
    for (int o = 1; o < 64; o <<= 1) { float t[4];
#pragma unroll
        for (int r = 0; r < 4; ++r) t[r] = __shfl_xor(v[r], o);
#pragma unroll
        for (int r = 0; r < 4; ++r) v[r] += t[r]; }
}

__device__ __forceinline__ int k_img(int key, int d) { return (d >> 4) * 2048 + ((d >> 3) & 1) * 1024 + (key >> 5) * 512 + (key & 31) * 16 + (d & 7) * 2; }
template <int NCB> __device__ __forceinline__ int v_img(int k, int c) { const int kk = k; return ((kk >> 3) * NCB + (c >> 5)) * 512 + ((kk & 7) * 32 + (c & 31)) * 2; }
__device__ __forceinline__ int v_rd_base(int lane) { return ((lane & 3) << 3) | (((lane >> 2) & 3) << 6) | (((lane >> 4) & 1) << 5) | (((lane >> 5) & 1) << 8); }

struct EpiProj {
    static constexpr bool PERM = true, AFTER_DRAIN = false;
    bf16* O; int ldc; unsigned char* ws;
    __device__ __forceinline__ void operator()(const pg8::f32x4 (&acc)[2][2][4][2], const pg8::Unit& u, int wr, int wc, int fr, int fq) const {
        const int row0 = u.pm * 256 + wr * 64 + fr;
#pragma unroll
        for (int ai = 0; ai < 2; ++ai)
#pragma unroll
            for (int m = 0; m < 4; ++m) {
                const int row = row0 + ai * 128 + m * 16;
                const int s = seq_of_row(row), sb = seq_base(s), n = seq_len(s), t = row - sb, tile = t >> 6, key = t & 63;
#pragma unroll
                for (int bj = 0; bj < 2; ++bj) {
                    const int cb = u.pn * 256 + bj * 128;
                    const int c = cb + wc * 32 + 8 * fq;
                    pg8::f32x4 v0 = acc[ai][bj][m][0], v1 = acc[ai][bj][m][1];
                    if (cb >= 768 && cb < 1280) { v0 = v0 * QSCALE; v1 = v1 * QSCALE; }
                    u32x4 w; w.x = pg8::cvt_pk_bf16(v0[0], v0[1]); w.y = pg8::cvt_pk_bf16(v0[2], v0[3]); w.z = pg8::cvt_pk_bf16(v1[0], v1[1]); w.w = pg8::cvt_pk_bf16(v1[2], v1[3]);
                    if (cb < 640) *(u32x4*)(O + (size_t)row * ldc + c) = w;
                    else if (cb < 768) { const int cc = c - 640; *(u32x4*)(ws + WS_VG + ((size_t)sb * 2 + (size_t)(cc >> 6) * n) * 128 + (size_t)tile * 8192 + v_img<2>(key, cc & 63)) = w; }
                    else if (cb < 1280) { const int cc = c - 768; *(u32x4*)(ws + WS_QD + ((size_t)sb * 8 + (size_t)(cc >> 6) * n + t) * 128 + (cc & 63) * 2) = w; }
                    else if (cb < 1792) { const int cc = c - 1280; *(u32x4*)(ws + WS_KD + ((size_t)sb * 8 + (size_t)(cc >> 6) * n) * 128 + (size_t)tile * 8192 + k_img(key, cc & 63)) = w; }
                    else { const int cc = c - 1792; *(u32x4*)(ws + WS_VD + ((size_t)sb * 4 + (size_t)(cc >> 7) * n) * 256 + (size_t)tile * 16384 + v_img<4>(key, cc & 127)) = w; }
                }
            }
    }
};

namespace att {
#define SBAR() __builtin_amdgcn_sched_barrier(0)
constexpr float THR = 8.f;
constexpr int SHM_V = 16384, SHM_K = 8192, NSLOT = 3;
constexpr int L_V = 0, L_K = NSLOT * SHM_V, L_WS = L_K + NSLOT * SHM_K, L_TAB = L_WS + NWAVES * 64 * 4, L_END = L_TAB + 2048;
static_assert(L_END <= 131072, "attention LDS");
__device__ __forceinline__ int crow(int r, int hi) { return (r & 3) + 8 * (r >> 2) + 4 * hi; }
__device__ __forceinline__ unsigned cvtpk(float lo, float hi) { unsigned r; asm volatile("v_cvt_pk_bf16_f32 %0, %1, %2" : "=v"(r) : "v"(lo), "v"(hi)); return r; }
__device__ __forceinline__ float max3f(float a, float b, float c) { float r; asm("v_max3_f32 %0, %1, %2, %3" : "=v"(r) : "v"(a), "v"(b), "v"(c)); return r; }
__device__ __forceinline__ void glds16(const void* gbase  , unsigned voff, unsigned lds_dst) { unsigned keep;
    asm volatile("s_mov_b32 %0, m0\n\ts_mov_b32 m0, %3\n\ts_nop 0\n\tglobal_load_lds_dwordx4 %1, %2\n\ts_mov_b32 m0, %0" : "=&s"(keep) : "v"(voff), "s"(gbase), "s"(lds_dst) : "memory"); }
#define WAIT_BAR() asm volatile("s_waitcnt vmcnt(0) lgkmcnt(0)\n\ts_barrier" ::: "memory")

template <bool BIAS, bool FIRST>
__device__ __forceinline__ void partialSM(f32x16& p0, f32x16& p1, float& m_reg, float& alpha, bool& moved, int bmode, const LAS float* tab, int idx0) {
    if constexpr (BIAS) {
        if (bmode == 2) {
#pragma unroll
            for (int r = 0; r < 16; ++r) { const int o = (r & 3) + 8 * (r >> 2); p0[r] += tab[idx0 + o]; p1[r] += tab[idx0 + 32 + o]; }
        }
    }
    float a = max3f(p0[0], p0[1], p1[0]), b = max3f(p0[2], p0[3], p1[1]); a = max3f(a, p1[2], p1[3]);
#pragma unroll
    for (int r = 4; r < 16; r += 4) { a = max3f(a, p0[r], p0[r + 1]); b = max3f(b, p0[r + 2], p0[r + 3]); a = max3f(a, p1[r], p1[r + 1]); b = max3f(b, p1[r + 2], p1[r + 3]); }
    float pmax = fmaxf(a, b);
    { auto rr = __builtin_amdgcn_permlane32_swap(__float_as_uint(pmax), __float_as_uint(pmax), false, false);
      pmax = fmaxf(__uint_as_float(rr[0]), __uint_as_float(rr[1])); }
    moved = false; alpha = 1.f;
    if (FIRST || !__builtin_expect(__all(pmax <= THR), 1)) {
        const float dl = FIRST ? pmax : fmaxf(pmax, 0.f);
        m_reg += dl; moved = true;
        if (!FIRST) alpha = __builtin_amdgcn_exp2f(-dl);
#pragma unroll
        for (int r = 0; r < 16; ++r) { p0[r] -= dl; p1[r] -= dl; }
    }
#pragma unroll
    for (int r = 0; r < 16; ++r) p0[r] = __builtin_amdgcn_exp2f(p0[r]);
}
__device__ __forceinline__ void finishSM(f32x16& p0, f32x16& p1, float alpha, float& l_reg, bf16x8& pa0, bf16x8& pa1, bf16x8& pa2, bf16x8& pa3) {
#pragma unroll
    for (int r = 0; r < 16; ++r) p1[r] = __builtin_amdgcn_exp2f(p1[r]);
    float ps = 0;
#pragma unroll
    for (int r = 0; r < 16; ++r) ps += p0[r];
#pragma unroll
    for (int r = 0; r < 16; ++r) ps += p1[r];
    { auto rr = __builtin_amdgcn_permlane32_swap(__float_as_uint(ps), __float_as_uint(ps), false, false);
      ps = __uint_as_float(rr[0]) + __uint_as_float(rr[1]); }
    l_reg = l_reg * alpha + ps;
#define PK4(P, BASE, OUT) do { unsigned a0 = cvtpk(P[BASE + 0], P[BASE + 1]), a1 = cvtpk(P[BASE + 2], P[BASE + 3]);   \
    unsigned b0 = cvtpk(P[BASE + 4], P[BASE + 5]), b1 = cvtpk(P[BASE + 6], P[BASE + 7]);                              \
    auto r0 = __builtin_amdgcn_permlane32_swap(a0, b0, false, false); auto r1 = __builtin_amdgcn_permlane32_swap(a1, b1, false, false); \
    u32x4 w = {r0[0], r1[0], r0[1], r1[1]}; OUT = __builtin_bit_cast(bf16x8, w); } while (0)
    PK4(p0, 0, pa0); PK4(p0, 8, pa1); PK4(p1, 0, pa2); PK4(p1, 8, pa3);
#undef PK4
}
__device__ __forceinline__ void qkt(f32x16& p0, f32x16& p1, const LAS char* Ks, const bf16x8* qr, const f32x16& negm, int r32, int hi) {
    const LAS char* kb = Ks + hi * 1024 + r32 * 16;
#pragma unroll
    for (int d0 = 0; d0 < 4; ++d0) {
        const bf16x8 b0 = *(const LAS bf16x8*)(kb + d0 * 2048);
        const bf16x8 b1 = *(const LAS bf16x8*)(kb + d0 * 2048 + 512);
        if (d0 == 0) { p0 = __builtin_amdgcn_mfma_f32_32x32x16_bf16(b0, qr[0], negm, 0, 0, 0); p1 = __builtin_amdgcn_mfma_f32_32x32x16_bf16(b1, qr[0], negm, 0, 0, 0); }
        else { p0 = __builtin_amdgcn_mfma_f32_32x32x16_bf16(b0, qr[d0], p0, 0, 0, 0); p1 = __builtin_amdgcn_mfma_f32_32x32x16_bf16(b1, qr[d0], p1, 0, 0, 0); } }
}
template <int OFF> __device__ __forceinline__ s16x4 tr_read(int vb) {
    s16x4 r; asm volatile("ds_read_b64_tr_b16 %0, %1 offset:%2" : "=&v"(r) : "v"(vb), "i"(OFF) : "memory"); return r;
}
template <int NCB> constexpr int v_rd_off(int d0, int ks, int half) { return d0 * 512 + (2 * ks + half) * NCB * 512; }
template <int NCB, int D0> __device__ __forceinline__ void pv_one(f32x16& od, int vb, bf16x8 pa0, bf16x8 pa1, bf16x8 pa2, bf16x8 pa3) {
    const s16x4 l0 = tr_read<v_rd_off<NCB>(D0, 0, 0)>(vb), h0 = tr_read<v_rd_off<NCB>(D0, 0, 1)>(vb), l1 = tr_read<v_rd_off<NCB>(D0, 1, 0)>(vb), h1 = tr_read<v_rd_off<NCB>(D0, 1, 1)>(vb);
    const s16x4 l2 = tr_read<v_rd_off<NCB>(D0, 2, 0)>(vb), h2 = tr_read<v_rd_off<NCB>(D0, 2, 1)>(vb), l3 = tr_read<v_rd_off<NCB>(D0, 3, 0)>(vb), h3 = tr_read<v_rd_off<NCB>(D0, 3, 1)>(vb);
    asm volatile("s_waitcnt lgkmcnt(0)" ::: "memory"); SBAR();
#define PK(L, H) (bf16x8){L[0], L[1], L[2], L[3], H[0], H[1], H[2], H[3]}
    od = __builtin_amdgcn_mfma_f32_32x32x16_bf16(pa0, PK(l0, h0), od, 0, 0, 0);
    od = __builtin_amdgcn_mfma_f32_32x32x16_bf16(pa1, PK(l1, h1), od, 0, 0, 0);
    od = __builtin_amdgcn_mfma_f32_32x32x16_bf16(pa2, PK(l2, h2), od, 0, 0, 0);
    od = __builtin_amdgcn_mfma_f32_32x32x16_bf16(pa3, PK(l3, h3), od, 0, 0, 0);
#undef PK
}
template <int NCB> __device__ __forceinline__ void pv_all(f32x16* o, int vb, bf16x8 pa0, bf16x8 pa1, bf16x8 pa2, bf16x8 pa3) {
    pv_one<NCB, 0>(o[0], vb, pa0, pa1, pa2, pa3); pv_one<NCB, 1>(o[1], vb, pa0, pa1, pa2, pa3);
    if constexpr (NCB == 4) { pv_one<NCB, 2>(o[2], vb, pa0, pa1, pa2, pa3); pv_one<NCB, 3>(o[3], vb, pa0, pa1, pa2, pa3); }
}

template <int NCB, bool DIFF>
__device__ __forceinline__ void attn_unit(LAS char* lds, const Params& P, int s, int head, int qb) {
    constexpr int NMAP = DIFF ? 2 : 1;
    constexpr int VB = NCB * 4096;
    int tid_ = threadIdx.x; asm volatile("" : "+v"(tid_));
    const int tid = tid_, lane = tid & 63, r32 = lane & 31, hi = lane >> 5; const int wid = __builtin_amdgcn_readfirstlane(tid >> 6);
    const int n = seq_len(s), sb = seq_base(s), NT = n >> 6, q0 = qb * 256;
    LAS float* wsf = (LAS float*)(lds + L_WS) + wid * 64; LAS float* li_l = wsf; LAS float* al_l = wsf + 32;
    LAS float* tab = (LAS float*)(lds + L_TAB);
    const unsigned lds0 = (unsigned)(uintptr_t)lds;
    const int vb0 = (int)(lds0 + L_V) + v_rd_base(lane);
    unsigned char* ws = P.ws;
    f32x16 o[NCB];
    float bL = 0.f, bR = 0.f;
    if constexpr (DIFF) {
        __syncthreads();
        { const int rel = tid - 256; const int nn = rel < 0 ? -rel : rel;
          int b = nn < 8 ? nn : (2 + (31 - __builtin_clz((unsigned)(nn * nn)))); b = b > 15 ? 15 : b; if (rel > 0) b += 16;
          tab[tid] = P.in[4][b * 4 + head] * LOG2E; }
        bL = P.in[4][15 * 4 + head] * LOG2E; bR = P.in[4][31 * 4 + head] * LOG2E;
    }
    const int qw = q0 + wid * 32;
#pragma unroll 1
    for (int mp = 0; mp < NMAP; ++mp) {
        const bf16* Qw; const unsigned char* Kimg; const unsigned char* Vimg;
        if constexpr (DIFF) {
            Qw = (const bf16*)(ws + WS_QD) + ((size_t)sb * 8 + (size_t)(head * 2 + mp) * n + qw) * 64;
            Kimg = ws + WS_KD + ((size_t)sb * 8 + (size_t)(head * 2 + mp) * n) * 128;
            Vimg = ws + WS_VD + ((size_t)sb * 4 + (size_t)head * n) * 256;
        } else {
            Qw = (const bf16*)(ws + WS_QG) + ((size_t)sb * 8 + (size_t)head * n + qw) * 64;
            Kimg = ws + WS_KG + ((size_t)sb * 2 + (size_t)(head >> 2) * n) * 128;
            Vimg = ws + WS_VG + ((size_t)sb * 2 + (size_t)(head >> 2) * n) * 128;
        }
        const unsigned dvoff = (unsigned)(wid * 1024 + lane * 16);
        const unsigned kdst = lds0 + L_K + wid * 1024, vdst = lds0 + L_V + wid * 1024;
#define DMA(t, slot) do { glds16(Kimg + (size_t)(t) * 8192, dvoff, (unsigned)__builtin_amdgcn_readfirstlane(kdst + (slot) * SHM_K)); \
        glds16(Vimg + (size_t)(t) * VB, dvoff, (unsigned)__builtin_amdgcn_readfirstlane(vdst + (slot) * SHM_V)); \
        if constexpr (NCB == 4) glds16(Vimg + (size_t)(t) * VB + 8192, dvoff, (unsigned)__builtin_amdgcn_readfirstlane(vdst + (slot) * SHM_V + 8192)); } while (0)
#define RESC(a) do { if (__any((a) < 1.f)) { if (hi == 0) al_l[r32] = (a); asm volatile("s_waitcnt lgkmcnt(0)" ::: "memory"); \
        _Pragma("unroll") for (int d = 0; d < NCB; ++d) _Pragma("unroll") for (int r = 0; r < 16; ++r) o[d][r] *= al_l[crow(r, hi)]; } } while (0)
#define BMODE(t) do { if constexpr (DIFF) { const int dd = (t) * 64 - qw; float cbn; if (dd <= -191) { bm = 1; cbn = bL; } else if (dd >= 159) { bm = 1; cbn = bR; } else { bm = 2; cbn = 0.f; } \
            ix = dd - r32 + 256 + 4 * hi; if (cbn != cb) { cb = cbn; moved = true; } } } while (0)
#define NEGM() do { if (moved) { const float v_ = cb - m_reg; _Pragma("unroll") for (int r = 0; r < 16; ++r) negm[r] = v_; asm volatile("" : "+v"(negm)); } } while (0)
        __syncthreads();
        DMA(0, 0); DMA(1, 1);
        bf16x8 qr[4];
#pragma unroll
        for (int d0 = 0; d0 < 4; ++d0) qr[d0] = *(const bf16x8*)(Qw + (size_t)r32 * 64 + d0 * 16 + hi * 8);
        float m_reg = 0.f, l_reg = 0.f, cb = 0.f; bool moved = true;
        f32x16 negm;
#pragma unroll
        for (int d = 0; d < NCB; ++d) o[d] = f32x16{};
        f32x16 pA0, pA1, pB0, pB1; float alA = 1.f, alB = 1.f; bf16x8 pa0, pa1, pa2, pa3;
        int bm = 0, ix = 0;
        WAIT_BAR();
        if (2 < NT) DMA(2, 2);
        BMODE(0); NEGM();
        qkt(pA0, pA1, lds + L_K, qr, negm, r32, hi); partialSM<DIFF, true>(pA0, pA1, m_reg, alA, moved, bm, tab, ix);
        int sl_prev = 0, sl_cur = 1, sl_next = 2;
#define ROT() do { const int t_ = sl_prev; sl_prev = sl_cur; sl_cur = sl_next; sl_next = t_; } while (0)
#define STEP(C0, C1, alC, P0, P1, alP, j) do { \
            BMODE(j); NEGM(); SBAR(); \
            qkt(C0, C1, lds + L_K + sl_cur * SHM_K, qr, negm, r32, hi); \
            finishSM(P0, P1, alP, l_reg, pa0, pa1, pa2, pa3); SBAR(); \
            pv_all<NCB>(o, vb0 + sl_prev * SHM_V, pa0, pa1, pa2, pa3); \
            partialSM<DIFF, false>(C0, C1, m_reg, alC, moved, bm, tab, ix); \
            WAIT_BAR(); \
            if ((j) + 2 < NT) DMA((j) + 2, sl_prev); \
            RESC(alC); ROT(); } while (0)
        for (int j = 1; j + 1 < NT; j += 2) {
            STEP(pB0, pB1, alB, pA0, pA1, alA, j);
            STEP(pA0, pA1, alA, pB0, pB1, alB, j + 1);
        }
        STEP(pB0, pB1, alB, pA0, pA1, alA, NT - 1);
        finishSM(pB0, pB1, alB, l_reg, pa0, pa1, pa2, pa3); SBAR();
        pv_all<NCB>(o, vb0 + sl_prev * SHM_V, pa0, pa1, pa2, pa3);
#undef DMA
#undef RESC
#undef BMODE
#undef NEGM
#undef ROT
#undef STEP
        if (hi == 0) li_l[r32] = l_reg; asm volatile("s_waitcnt lgkmcnt(0)" ::: "memory");
        float rli[16];
#pragma unroll
        for (int r = 0; r < 16; ++r) rli[r] = __builtin_amdgcn_rcpf(li_l[crow(r, hi)]);
        bf16* mixw = (bf16*)(ws + WS_MIX) + (size_t)(sb + qw) * DM;
        if constexpr (!DIFF) {
#pragma unroll
            for (int r = 0; r < 16; ++r) { const int orow = crow(r, hi);
#pragma unroll
                for (int d0 = 0; d0 < NCB; ++d0) mixw[(size_t)orow * DM + head * 64 + d0 * 32 + r32] = (bf16)f2bf(o[d0][r] * rli[r]); }
        } else {
            if (mp == 0) {
#pragma unroll
                for (int r = 0; r < 16; ++r) { const int orow = crow(r, hi);
#pragma unroll
                    for (int d0 = 0; d0 < NCB; ++d0) mixw[(size_t)orow * DM + 512 + head * 128 + d0 * 32 + r32] = (bf16)f2bf(o[d0][r] * rli[r]); }
            } else {
                const float lam = *(const float*)(ws + WS_LAM);
                float ss[16];
#pragma unroll
                for (int r = 0; r < 16; ++r) ss[r] = 0.f;
#pragma unroll
                for (int d0 = 0; d0 < NCB; ++d0)
#pragma unroll
                    for (int r = 0; r < 16; ++r) { const float o1 = bf2f(mixw[(size_t)crow(r, hi) * DM + 512 + head * 128 + d0 * 32 + r32]);
                        const float a0 = o1 - lam * (o[d0][r] * rli[r]); o[d0][r] = a0; ss[r] += a0 * a0; }
#pragma unroll
                for (int r = 0; r < 16; ++r) {
#pragma unroll
                    for (int of = 1; of < 32; of <<= 1) ss[r] += __shfl_xor(ss[r], of);
                    ss[r] = __builtin_amdgcn_rsqf(ss[r] * (1.0f / 128.0f) + EPS) * 0.8f;
                }
                float gs[NCB];
#pragma unroll
                for (int d0 = 0; d0 < NCB; ++d0) gs[d0] = P.in[15][d0 * 32 + r32];
#pragma unroll
                for (int r = 0; r < 16; ++r) { const int orow = crow(r, hi);
#pragma unroll
                    for (int d0 = 0; d0 < NCB; ++d0) mixw[(size_t)orow * DM + 512 + head * 128 + d0 * 32 + r32] = (bf16)f2bf(o[d0][r] * ss[r] * gs[d0]); }
            }
        }
    }
}
#undef SBAR
#undef WAIT_BAR
}

namespace att2 {
#define SBAR() __builtin_amdgcn_sched_barrier(0)
constexpr float THR = 8.f;
constexpr int SHM_V = 16384, SHM_K = 8192, NSLOT = 5;
constexpr int L_V = 0, L_K = NSLOT * SHM_V, L_WS = L_K + NSLOT * SHM_K, L_TAB = L_WS + NWAVES * 64 * 4, L_END = L_TAB + 2048;
static_assert(L_END <= 131072, "attention LDS");
__device__ __forceinline__ int crow(int r, int hi) { return (r & 3) + 8 * (r >> 2) + 4 * hi; }
__device__ __forceinline__ unsigned cvtpk(float lo, float hi) { unsigned r; asm volatile("v_cvt_pk_bf16_f32 %0, %1, %2" : "=v"(r) : "v"(lo), "v"(hi)); return r; }
__device__ __forceinline__ float max3f(float a, float b, float c) { float r; asm("v_max3_f32 %0, %1, %2, %3" : "=v"(r) : "v"(a), "v"(b), "v"(c)); return r; }
__device__ __forceinline__ void glds16(const void* gbase, unsigned voff, unsigned lds_dst) { unsigned keep;
    asm volatile("s_mov_b32 %0, m0\n\ts_mov_b32 m0, %3\n\ts_nop 0\n\tglobal_load_lds_dwordx4 %1, %2\n\ts_mov_b32 m0, %0" : "=&s"(keep) : "v"(voff), "s"(gbase), "s"(lds_dst) : "memory"); }
#define WAIT_BAR() asm volatile("s_waitcnt vmcnt(0) lgkmcnt(0)\n\ts_barrier" ::: "memory")

template <bool BIAS>
__device__ __forceinline__ void bias_add(f32x16& p0, f32x16& p1, int bmode, const LAS float* tab, int idx0) {
    if constexpr (BIAS) {
        if (bmode == 2) {
#pragma unroll
            for (int r = 0; r < 16; ++r) { const int o = (r & 3) + 8 * (r >> 2); p0[r] += tab[idx0 + o]; p1[r] += tab[idx0 + 32 + o]; if ((r & 3) == 3) { asm volatile("" : "+v"(p0), "+v"(p1)); SBAR(); } }
        }
    }
}
template <bool BIAS, bool FIRST>
__device__ __forceinline__ void rowmax_decide(f32x16& p0, f32x16& p1, float& m_reg, float& alpha, bool& moved, int bmode, const LAS float* tab, int idx0) {
    float a = max3f(p0[0], p0[1], p1[0]), b = max3f(p0[2], p0[3], p1[1]); a = max3f(a, p1[2], p1[3]);
#pragma unroll
    for (int r = 4; r < 16; r += 4) { a = max3f(a, p0[r], p0[r + 1]); b = max3f(b, p0[r + 2], p0[r + 3]); a = max3f(a, p1[r], p1[r + 1]); b = max3f(b, p1[r + 2], p1[r + 3]); }
    float pmax = fmaxf(a, b);
    { auto rr = __builtin_amdgcn_permlane32_swap(__float_as_uint(pmax), __float_as_uint(pmax), false, false);
      pmax = fmaxf(__uint_as_float(rr[0]), __uint_as_float(rr[1])); }
    moved = false; alpha = 1.f;
    if (FIRST || !__builtin_expect(__all(pmax <= THR), 1)) {
        const float dl = FIRST ? pmax : fmaxf(pmax, 0.f);
        m_reg += dl; moved = true;
        if (!FIRST) alpha = __builtin_amdgcn_exp2f(-dl);
#pragma unroll
        for (int r = 0; r < 16; ++r) { p0[r] -= dl; p1[r] -= dl; }
    }
}
__device__ __forceinline__ s16x4 tr_rd(const LAS char* p) {
    typedef short v4i16_t __attribute__((ext_vector_type(4)));
    return __builtin_bit_cast(s16x4, __builtin_amdgcn_ds_read_tr16_b64_v4i16((LAS v4i16_t*)p));
}
#define PKV(L, H) (bf16x8){L[0], L[1], L[2], L[3], H[0], H[1], H[2], H[3]}
#define PKW(P, B) cvtpk(P[B], P[B + 1])
#define MFMA32(a, b, c) __builtin_amdgcn_mfma_f32_32x32x16_bf16(a, b, c, 0, 0, 0)

template <int NCB, bool DIFF, bool STAT>
__device__ __forceinline__ void attn_unit(LAS char* lds, const Params& P, int s, int head, int qb, float sref) {
    constexpr int NMAP = DIFF ? 2 : 1;
    constexpr int VB = NCB * 4096;
    constexpr int NG = 4 * NCB, EPG = 32 / NG;
    constexpr bool KJ = (NCB == 4);
    int tid_ = threadIdx.x; asm volatile("" : "+v"(tid_));
    const int tid = tid_, lane = tid & 63, r32 = lane & 31, hi = lane >> 5; const int wid = __builtin_amdgcn_readfirstlane(tid >> 6);
    const int n = seq_len(s), sb = seq_base(s), NT = n >> 6, q0 = qb * 256;
    LAS float* wsf = (LAS float*)(lds + L_WS) + wid * 64; LAS float* li_l = wsf; LAS float* al_l = wsf + 32;
    LAS float* tab = (LAS float*)(lds + L_TAB);
    const unsigned lds0 = (unsigned)(uintptr_t)lds;
    const LAS char* vp0 = lds + L_V + v_rd_base(lane);
    const LAS char* kp0 = lds + L_K + hi * 1024 + r32 * 16;
    unsigned char* ws = P.ws;
    f32x16 o[NCB];
    float bL = 0.f, bR = 0.f;
    if constexpr (DIFF) {
        __syncthreads();
        { const int rel = tid - 256; const int nn = rel < 0 ? -rel : rel;
          int b = nn < 8 ? nn : (2 + (31 - __builtin_clz((unsigned)(nn * nn)))); b = b > 15 ? 15 : b; if (rel > 0) b += 16;
          tab[tid] = P.in[4][b * 4 + head] * LOG2E; }
        bL = P.in[4][15 * 4 + head] * LOG2E; bR = P.in[4][31 * 4 + head] * LOG2E;
    }
    const int qw = q0 + wid * 32;
#pragma unroll 1
    for (int mp = 0; mp < NMAP; ++mp) {
        const bf16* Qw; const unsigned char* Kimg; const unsigned char* Vimg;
        if constexpr (DIFF) {
            Qw = (const bf16*)(ws + WS_QD) + ((size_t)sb * 8 + (size_t)(head * 2 + mp) * n + qw) * 64;
            Kimg = ws + WS_KD + ((size_t)sb * 8 + (size_t)(head * 2 + mp) * n) * 128;
            Vimg = ws + WS_VD + ((size_t)sb * 4 + (size_t)head * n) * 256;
        } else {
            Qw = (const bf16*)(ws + WS_QG) + ((size_t)sb * 8 + (size_t)head * n + qw) * 64;
            Kimg = ws + WS_KG + ((size_t)sb * 2 + (size_t)(head >> 2) * n) * 128;
            Vimg = ws + WS_VG + ((size_t)sb * 2 + (size_t)(head >> 2) * n) * 128;
        }
        const unsigned dvoff = (unsigned)(wid * 1024 + lane * 16);
        const unsigned kdst = lds0 + L_K + wid * 1024, vdst = lds0 + L_V + wid * 1024;
#define DMA(t, slot) do { glds16(Kimg + (size_t)(t) * 8192, dvoff, (unsigned)__builtin_amdgcn_readfirstlane(kdst + (slot) * SHM_K)); \
        glds16(Vimg + (size_t)(t) * VB, dvoff, (unsigned)__builtin_amdgcn_readfirstlane(vdst + (slot) * SHM_V)); \
        if constexpr (NCB == 4) glds16(Vimg + (size_t)(t) * VB + 8192, dvoff, (unsigned)__builtin_amdgcn_readfirstlane(vdst + (slot) * SHM_V + 8192)); } while (0)
#define RESC(a) do { if (__any((a) < 1.f)) { if (hi == 0) al_l[r32] = (a); asm volatile("s_waitcnt lgkmcnt(0)" ::: "memory"); \
        _Pragma("unroll") for (int d = 0; d < NCB; ++d) _Pragma("unroll") for (int r = 0; r < 16; ++r) o[d][r] *= al_l[crow(r, hi)]; } } while (0)
#define BMODE(t) do { if constexpr (DIFF) { const int dd = (t) * 64 - qw; float cbn; if (dd <= -191) { bm = 1; cbn = bL; } else if (dd >= 159) { bm = 1; cbn = bR; } else { bm = 2; cbn = 0.f; } \
            ix = dd - r32 + 256 + 4 * hi; if (cbn != cb) { cb = cbn; moved = true; } } } while (0)
#define NEGM() do { if (moved) { const float v_ = cb - m_reg; _Pragma("unroll") for (int r = 0; r < 16; ++r) negm[r] = v_; asm volatile("" : "+v"(negm)); } } while (0)
        __syncthreads();
        DMA(0, 0); DMA(1, 1); DMA(2, 2);
        bf16x8 qr[4];
#pragma unroll
        for (int d0 = 0; d0 < 4; ++d0) qr[d0] = *(const bf16x8*)(Qw + (size_t)r32 * 64 + d0 * 16 + hi * 8);
        constexpr bool ZREF = STAT && !DIFF;
        float m_reg = (STAT && !ZREF) ? sref : 0.f, l_reg = 0.f, cb = 0.f; bool moved = true;
        if constexpr (STAT && DIFF) {
            float q2 = 0.f;
#pragma unroll
            for (int d0 = 0; d0 < 4; ++d0)
#pragma unroll
                for (int i = 0; i < 8; ++i) { const float f = __builtin_bit_cast(float, (unsigned)(unsigned short)qr[d0][i] << 16); q2 += f * f; }
            { auto rr = __builtin_amdgcn_permlane32_swap(__float_as_uint(q2), __float_as_uint(q2), false, false); q2 = __uint_as_float(rr[0]) + __uint_as_float(rr[1]); }
            const float kn2 = __uint_as_float(((const unsigned*)(ws + WS_BAR))[3800 + s * 8 + head * 2 + mp]);
            m_reg = __builtin_sqrtf(q2 * kn2) * 1.001f + 0.01f + sref;
        }
        f32x16 negm;
#pragma unroll
        for (int d = 0; d < NCB; ++d) o[d] = f32x16{};
        f32x16 pA0, pA1, pB0, pB1; float alA = 1.f, alB = 1.f;
        u32x4 pw[4];
        int bm = 0, ix = 0;
        WAIT_BAR();
        BMODE(0); NEGM();
        { const LAS char* kp_ = kp0;
#pragma unroll
          for (int d0 = 0; d0 < 4; ++d0) { const bf16x8 b0 = *(const LAS bf16x8*)(kp_ + d0 * 2048), b1 = *(const LAS bf16x8*)(kp_ + d0 * 2048 + 512);
              if (d0 == 0) { if constexpr (ZREF) { pA0 = MFMA32(b0, qr[0], f32x16{}); pA1 = MFMA32(b1, qr[0], f32x16{}); } else { pA0 = MFMA32(b0, qr[0], negm); pA1 = MFMA32(b1, qr[0], negm); } } else { pA0 = MFMA32(b0, qr[d0], pA0); pA1 = MFMA32(b1, qr[d0], pA1); } } }
        bias_add<DIFF>(pA0, pA1, bm, tab, ix);
        if constexpr (!STAT) rowmax_decide<DIFF, true>(pA0, pA1, m_reg, alA, moved, bm, tab, ix); else moved = false;
#pragma unroll
        for (int r = 0; r < 16; ++r) { pA0[r] = __builtin_amdgcn_exp2f(pA0[r]); pA1[r] = __builtin_amdgcn_exp2f(pA1[r]); }
        int sl_prev = 0, sl_cur = 1;
        bf16x8 kf[3];
#define ROT() do { sl_prev = sl_cur; sl_cur = (sl_cur == 4) ? 0 : sl_cur + 1; } while (0)
#define ADD5(x, k) (((x) + (k) >= 5) ? (x) + (k) - 5 : (x) + (k))
#define KRD(g) do { kf[(g) % 3] = *(const LAS bf16x8*)(kp_ + ((g) >> 1) * 2048 + ((g) & 1) * 512); } while (0)
#define VRD(g) do { const int o_ = ((g) % NCB) * 512 + (2 * ((g) / NCB)) * NCB * 512; vl[(g) % 3] = tr_rd(vp_ + o_); vh[(g) % 3] = tr_rd(vp_ + o_ + NCB * 512); } while (0)
#define STEP(C0, C1, alC, P0, P1, alP, j, WB, KPRE) do { \
            BMODE(j); NEGM(); SBAR(); \
            const LAS char* kp_ = kp0 + sl_cur * SHM_K; const LAS char* vp_ = vp0 + sl_prev * SHM_V; \
            s16x4 vl[3], vh[3]; \
            if (!(KPRE)) { KRD(0); KRD(1); } \
            float s0_ = 0.f, s1_ = 0.f; \
            SBAR(); \
            _Pragma("unroll") for (int g = 0; g < 8; ++g) { \
                if (g + 2 < 8) KRD(g + 2); \
                if ((g & 1) == 0) C0 = MFMA32(kf[g % 3], qr[g >> 1], (g < 2) ? (ZREF ? f32x16{} : negm) : C0); else C1 = MFMA32(kf[g % 3], qr[g >> 1], (g < 2) ? (ZREF ? f32x16{} : negm) : C1); \
                if (g < 4) { s0_ += P0[4 * g]; s1_ += P0[4 * g + 1]; s0_ += P0[4 * g + 2]; s1_ += P0[4 * g + 3]; \
                             pw[g >> 1][(g & 1) * 2] = PKW(P0, 4 * g); pw[g >> 1][(g & 1) * 2 + 1] = PKW(P0, 4 * g + 2); } \
                else { s0_ += P1[4 * g - 16]; s1_ += P1[4 * g - 15]; s0_ += P1[4 * g - 14]; s1_ += P1[4 * g - 13]; \
                       pw[g >> 1][(g & 1) * 2] = PKW(P1, 4 * g - 16); pw[g >> 1][(g & 1) * 2 + 1] = PKW(P1, 4 * g - 14); } \
                asm volatile("" : "+v"(s0_), "+v"(s1_)); \
                if (g == 6) VRD(0); if (g == 7) VRD(1); \
                SBAR(); } \
            if constexpr (STAT) l_reg += (s0_ + s1_); else l_reg = l_reg * alP + (s0_ + s1_); \
            if (!(WB)) { if ((j) + 2 < NT) DMA((j) + 2, ADD5(sl_cur, 2)); if ((j) + 3 < NT) DMA((j) + 3, ADD5(sl_cur, 3)); } \
            bias_add<DIFF>(C0, C1, bm, tab, ix); \
            if constexpr (!STAT) { rowmax_decide<DIFF, false>(C0, C1, m_reg, alC, moved, bm, tab, ix); SBAR(); } else { moved = false; } \
            _Pragma("unroll") for (int g = 0; g < NG; ++g) { \
                if (g + 2 < NG) VRD(g + 2); \
                o[g % NCB] = MFMA32(__builtin_bit_cast(bf16x8, pw[g / NCB]), PKV(vl[g % 3], vh[g % 3]), o[g % NCB]); \
                _Pragma("unroll") for (int i = 0; i < EPG; ++i) { const int e = g * EPG + i; if (e < 16) C0[e] = __builtin_amdgcn_exp2f(C0[e]); else C1[e - 16] = __builtin_amdgcn_exp2f(C1[e - 16]); } \
                if (g * EPG < 16) asm volatile("" : "+v"(C0)); else asm volatile("" : "+v"(C1)); \
                SBAR(); } \
            if (!(WB) && (j) + 1 < NT) { const LAS char* kn_ = kp0 + ADD5(sl_cur, 1) * SHM_K; kf[0] = *(const LAS bf16x8*)(kn_); kf[1] = *(const LAS bf16x8*)(kn_ + 512); } \
            if (WB) { WAIT_BAR(); } \
            if constexpr (!STAT) { RESC(alC); } ROT(); } while (0)
        for (int j = 1; j + 1 < NT; j += 2) {
            STEP(pB0, pB1, alB, pA0, pA1, alA, j, false, false);
            STEP(pA0, pA1, alA, pB0, pB1, alB, j + 1, true, true);
        }
        STEP(pB0, pB1, alB, pA0, pA1, alA, NT - 1, false, false);
        { const LAS char* vp_ = vp0 + sl_prev * SHM_V; s16x4 vl[3], vh[3];
          float s0_ = 0.f;
#pragma unroll
          for (int r = 0; r < 16; ++r) s0_ += pB0[r] + pB1[r];
          if constexpr (STAT) l_reg += s0_; else l_reg = l_reg * alB + s0_;
          pw[0] = (u32x4){PKW(pB0, 0), PKW(pB0, 2), PKW(pB0, 4), PKW(pB0, 6)}; pw[1] = (u32x4){PKW(pB0, 8), PKW(pB0, 10), PKW(pB0, 12), PKW(pB0, 14)};
          pw[2] = (u32x4){PKW(pB1, 0), PKW(pB1, 2), PKW(pB1, 4), PKW(pB1, 6)}; pw[3] = (u32x4){PKW(pB1, 8), PKW(pB1, 10), PKW(pB1, 12), PKW(pB1, 14)};
#pragma unroll
          for (int g = 0; g < NG; ++g) { VRD(g); o[g % NCB] = MFMA32(__builtin_bit_cast(bf16x8, pw[g / NCB]), PKV(vl[g % 3], vh[g % 3]), o[g % NCB]); } }
#undef DMA
#undef RESC
#undef BMODE
#undef NEGM
#undef ROT
#undef ADD5
#undef STEP
#undef VRD
#undef KRD
        { auto rr = __builtin_amdgcn_permlane32_swap(__float_as_uint(l_reg), __float_as_uint(l_reg), false, false); l_reg = __uint_as_float(rr[0]) + __uint_as_float(rr[1]); }
        if (hi == 0) li_l[r32] = l_reg; asm volatile("s_waitcnt lgkmcnt(0)" ::: "memory");
        float rli[16];
#pragma unroll
        for (int r = 0; r < 16; ++r) rli[r] = __builtin_amdgcn_rcpf(li_l[crow(r, hi)]);
        bf16* mixw = (bf16*)(ws + WS_MIX) + (size_t)(sb + qw) * DM;
        if constexpr (!DIFF) {
#pragma unroll
            for (int r = 0; r < 16; ++r) { const int orow = crow(r, hi);
#pragma unroll
                for (int d0 = 0; d0 < NCB; ++d0) mixw[(size_t)orow * DM + head * 64 + d0 * 32 + r32] = (bf16)f2bf(o[d0][r] * rli[r]); }
        } else {
            if (mp == 0) {
#pragma unroll
                for (int r = 0; r < 16; ++r) { const int orow = crow(r, hi);
#pragma unroll
                    for (int d0 = 0; d0 < NCB; ++d0) mixw[(size_t)orow * DM + 512 + head * 128 + d0 * 32 + r32] = (bf16)f2bf(o[d0][r] * rli[r]); }
            } else {
                const float lam = *(const float*)(ws + WS_LAM);
                float ss[16];
#pragma unroll
                for (int r = 0; r < 16; ++r) ss[r] = 0.f;
#pragma unroll
                for (int d0 = 0; d0 < NCB; ++d0)
#pragma unroll
                    for (int r = 0; r < 16; ++r) { const float o1 = bf2f(mixw[(size_t)crow(r, hi) * DM + 512 + head * 128 + d0 * 32 + r32]);
                        const float a0 = o1 - lam * (o[d0][r] * rli[r]); o[d0][r] = a0; ss[r] += a0 * a0; }
#pragma unroll
                for (int r = 0; r < 16; ++r) {
#pragma unroll
                    for (int of = 1; of < 32; of <<= 1) ss[r] += __shfl_xor(ss[r], of);
                    ss[r] = __builtin_amdgcn_rsqf(ss[r] * (1.0f / 128.0f) + EPS) * 0.8f;
                }
                float gs[NCB];
#pragma unroll
                for (int d0 = 0; d0 < NCB; ++d0) gs[d0] = P.in[15][d0 * 32 + r32];
#pragma unroll
                for (int r = 0; r < 16; ++r) { const int orow = crow(r, hi);
#pragma unroll
                    for (int d0 = 0; d0 < NCB; ++d0) mixw[(size_t)orow * DM + 512 + head * 128 + d0 * 32 + r32] = (bf16)f2bf(o[d0][r] * ss[r] * gs[d0]); }
            }
        }
    }
}
#undef SBAR
#undef WAIT_BAR
#undef PKV
#undef PKW
#undef MFMA32
}

__device__ __forceinline__ void attn_decode(int L, int& diff, int& s, int& head, int& qb) {
    if (L < 512) { const int round = L >> 8, v = L & 255, x = v >> 5, l = v & 31; diff = 1; s = x >> 2; head = x & 3; qb = l + 32 * round; }
    else if (L < 1536) { const int Lp = L - 512, round = Lp >> 8, v = Lp & 255, x = v >> 5, l = v & 31, st = x >> 1; diff = 0; s = st >> 1; head = (st & 1) * 4 + round; qb = 32 * (x & 1) + l; }
    else if (L < 2048) { const int Lp = L - 1536, round = Lp >> 8, v = Lp & 255, x = v >> 5, l = v & 31, i = round * 32 + l; diff = 0; s = 2 + (x >> 1); head = (x & 1) * 4 + (i >> 4); qb = i & 15; }
    else { const int v = L - 2048, x = v >> 5, l = v & 31, st = 2 * x + (l >> 4); diff = 1; s = 2 + (st >> 2); head = st & 3; qb = l & 15; }
}

__device__ __forceinline__ void p0_transpose_item(const float* W, int K, int N, bf16* WT, int k0, int n0, int drow0, LAS float* scr, int lane) {
#pragma unroll 8
    for (int i = 0; i < 32; ++i) { const int kk = 2 * i + (lane >> 5); scr[kk * 33 + (lane & 31)] = W[(size_t)(k0 + kk) * N + n0 + (lane & 31)]; }
    asm volatile("s_waitcnt lgkmcnt(0)" ::: "memory");
    const int c = lane & 7;
#pragma unroll
    for (int j = 0; j < 4; ++j) { const int n = (lane >> 3) + 8 * j; const LAS float* sp = scr + (8 * c) * 33 + n;
        u32x4 o; o.x = pk2(sp[0 * 33], sp[1 * 33]); o.y = pk2(sp[2 * 33], sp[3 * 33]); o.z = pk2(sp[4 * 33], sp[5 * 33]); o.w = pk2(sp[6 * 33], sp[7 * 33]);
        *(u32x4*)(WT + (size_t)(drow0 + n) * K + k0 + 8 * c) = o; }
    asm volatile("s_waitcnt lgkmcnt(0)" ::: "memory");
}

__device__ __forceinline__ void norm_rope8(float (&v)[8], int c8, const float* g, const float* ropetab, int pos_r, int pos_c) {
    float ss = 0.f;
#pragma unroll
    for (int i = 0; i < 8; ++i) ss += v[i] * v[i];
    ss += __shfl_xor(ss, 1); ss += __shfl_xor(ss, 2); ss += __shfl_xor(ss, 4);
    const float rstd = __builtin_amdgcn_rsqf(ss * (1.0f / 64.0f) + EPS);
#pragma unroll
    for (int i = 0; i < 8; ++i) v[i] = v[i] * rstd * g[c8 * 8 + i];
    float pv[8];
#pragma unroll
    for (int i = 0; i < 8; ++i) pv[i] = __shfl_xor(v[i], 2);
    const int a = c8 >> 2, cc = c8 & 3, second = cc >> 1, i16 = (cc & 1) * 8;
    const float* tb = ropetab + ((size_t)(a ? pos_c : pos_r) * 16 + i16) * 2;
#pragma unroll
    for (int i = 0; i < 8; ++i) { const float cs = tb[2 * i], sn = tb[2 * i + 1]; v[i] = second ? (v[i] * cs + pv[i] * sn) : (v[i] * cs - pv[i] * sn); }
}
__device__ __forceinline__ void ld8bf(const bf16* p, float (&v)[8]) { const u32x4 w = *(const u32x4*)p; v[0] = bflo(w.x); v[1] = bfhi(w.x); v[2] = bflo(w.y); v[3] = bfhi(w.y); v[4] = bflo(w.z); v[5] = bfhi(w.z); v[6] = bflo(w.w); v[7] = bfhi(w.w); }
__device__ __forceinline__ u32x4 pk8(const float (&v)[8], float sc) { u32x4 w; w.x = pk2(v[0] * sc, v[1] * sc); w.y = pk2(v[2] * sc, v[3] * sc); w.z = pk2(v[4] * sc, v[5] * sc); w.w = pk2(v[6] * sc, v[7] * sc); return w; }

#define XB_TMO      128
#define XB_XCNT(j)  (256  + 64 * (j))
#define XB_XSUB(j)  (1280 + 64 * (j))
#define XB_XGEN(j)  (2304 + 64 * (j))
#define XB_TOP      3328
#define XB_TOPGEN   3392
#define XCD_BAR_WORDS 3456
#define XB_SPIN_CAP (1u << 18)
__device__ __forceinline__ unsigned xb_ld(unsigned* p)              { return __hip_atomic_load(p, __ATOMIC_RELAXED, __HIP_MEMORY_SCOPE_AGENT); }
__device__ __forceinline__ unsigned xb_add(unsigned* p, unsigned v) { return __hip_atomic_fetch_add(p, v, __ATOMIC_RELAXED, __HIP_MEMORY_SCOPE_AGENT); }
__device__ __forceinline__ unsigned xb_xcc_id() { return (unsigned)__builtin_amdgcn_s_getreg((3 << 11) | 20) & 0xFu; }
#define XB_SPIN(cond, bar) do { unsigned _sp = 0; while (cond) { __builtin_amdgcn_s_sleep(1); \
    if ((++_sp & 255u) == 0u) { if (xb_ld(&(bar)[XB_TMO])) break; if (_sp > XB_SPIN_CAP) { atomicAdd(&(bar)[XB_TMO], 1u); break; } } } } while (0)
struct XcdBarrier { unsigned* bar; unsigned x; volatile LAS unsigned* st; };
__device__ __forceinline__ XcdBarrier xcd_barrier_post(unsigned* bar, volatile LAS unsigned* st) {
    XcdBarrier b; b.bar = bar; b.x = xb_xcc_id(); b.st = st;
    if (threadIdx.x == 0) (void)xb_add(&bar[XB_XCNT(b.x)], 1u);
    return b;
}
__device__ __forceinline__ void xcd_barrier_complete(unsigned* bar, unsigned x, unsigned& nloc, unsigned& nx) {
    const unsigned G = gridDim.x * gridDim.y * gridDim.z;
    unsigned sum, cnt, mine, sp = 0u;
    for (;;) {
        sum = 0u; cnt = 0u; mine = 0u;
#pragma unroll
        for (unsigned j = 0; j < 16; ++j) { const unsigned c = xb_ld(&bar[XB_XCNT(j)]); sum += c; cnt += (c > 0u) ? 1u : 0u; mine = (j == x) ? c : mine; }
        if (sum == G) break;
        __builtin_amdgcn_s_sleep(1);
        if ((++sp & 255u) == 0u) { if (xb_ld(&bar[XB_TMO])) break; if (sp > XB_SPIN_CAP) { atomicAdd(&bar[XB_TMO], 1u); break; } }
    }
    nloc = mine > 0u ? mine : 1u; nx = cnt > 0u ? cnt : 1u;
}
__device__ __forceinline__ void xcd_barrier(const XcdBarrier& b) {
    asm volatile("s_waitcnt vmcnt(0)" ::: "memory");
    __syncthreads();
    if (threadIdx.x == 0) {
        unsigned* bar = b.bar;
        __builtin_amdgcn_s_waitcnt(0);
        unsigned nloc = b.st[0], nx = b.st[1];
        if (nloc == 0u) { xcd_barrier_complete(bar, b.x, nloc, nx); b.st[0] = nloc; b.st[1] = nx; }
        const unsigned old = xb_add(&bar[XB_XSUB(b.x)], 1u);
        const unsigned gen = old / nloc;
        if (old + 1u == (gen + 1u) * nloc) {
            __builtin_amdgcn_fence(__ATOMIC_RELEASE, "agent");
            asm volatile("s_waitcnt vmcnt(0)" ::: "memory");
            const unsigned og = xb_add(&bar[XB_TOP], 1u);
            const unsigned tg = og / nx;
            if (og + 1u == (tg + 1u) * nx) xb_add(&bar[XB_TOPGEN], 1u);
            else XB_SPIN(xb_ld(&bar[XB_TOPGEN]) == tg, bar);
            __builtin_amdgcn_fence(__ATOMIC_ACQUIRE, "agent");
            xb_add(&bar[XB_XGEN(b.x)], 1u);
            asm volatile("s_waitcnt vmcnt(0)" ::: "memory");
        } else {
            XB_SPIN(xb_ld(&bar[XB_XGEN(b.x)]) == gen, bar);
            __builtin_amdgcn_fence(__ATOMIC_ACQUIRE, "agent");
            asm volatile("s_waitcnt vmcnt(0)" ::: "memory");
        }
    }
    __syncthreads();
}

__global__ void __launch_bounds__(NWAVES * 64, 2) fwd_megakernel(Params P) {
    extern __shared__ __attribute__((aligned(16))) unsigned char lds_raw[];
    cg::grid_group grid = cg::this_grid();
    LAS unsigned char* lds = (LAS unsigned char*)lds_raw;
    const int G = gridDim.x, bx = blockIdx.x;
    const int vcu = (G % 8 == 0) ? (bx % 8) * (G / 8) + bx / 8 : bx;
    const int NGW = G * NWAVES;
#define IDS() int tid_ = threadIdx.x; asm volatile("" : "+v"(tid_)); const int tid = tid_, lane = tid & 63; const int wave = __builtin_amdgcn_readfirstlane(tid >> 6); const int gw = vcu * NWAVES + wave; (void)gw; (void)lane
    unsigned char* ws = P.ws;
    float* mod = (float*)(ws + WS_MOD);
    const float* ropetab = (const float*)(ws + WS_ROPE);
    volatile LAS unsigned* bst = (volatile LAS unsigned*)(lds + 131072);
    if (threadIdx.x < 2) bst[threadIdx.x] = 0u;
    __syncthreads();
    if (blockIdx.x == 0) { for (int i = threadIdx.x; i < (int)(BAR_ZERO_BYTES / 4); i += NWAVES * 64) ((unsigned*)(ws + WS_BAR))[i] = 0u; }

    {
        IDS();
        LAS float* scr = (LAS float*)(lds + wave * 16384);
        constexpr int I_IN = 16 * 72, I_OUT = 16 * 32, I_GU = 16 * 176, I_DN = 44 * 32, NITEMS = I_IN + I_OUT + I_GU + I_DN;
        for (int it = gw; it < NITEMS; it += NGW) {
            int r = it;
            if (r < I_IN) { const int kb = r / 72, nb = r % 72; p0_transpose_item(P.in[8], 1024, INW, (bf16*)(ws + WS_WIN), 64 * kb, 32 * nb, 32 * nb, scr, lane); continue; } r -= I_IN;
            if (r < I_OUT) { const int kb = r / 32, nb = r % 32; p0_transpose_item(P.in[16], 1024, DM, (bf16*)(ws + WS_WOUT), 64 * kb, 32 * nb, 32 * nb, scr, lane); continue; } r -= I_OUT;
            if (r < I_GU) { const int kb = r / 176, nb = r % 176; const int n0 = 32 * nb; const int j0 = n0 < DFF ? n0 : n0 - DFF;
                const int drow = (j0 >> 7) * 256 + (n0 < DFF ? 0 : 128) + (j0 & 127);
                p0_transpose_item(P.in[19], 1024, 2 * DFF, (bf16*)(ws + WS_WGU), 64 * kb, n0, drow, scr, lane); continue; } r -= I_GU;
            { const int kb = r / 32, nb = r % 32; p0_transpose_item(P.in[20], DFF, DM, (bf16*)(ws + WS_WDN), 64 * kb, 32 * nb, 32 * nb, scr, lane); }
        }
        __syncthreads();
        LAS float* sc = (LAS float*)lds;
        LAS float* part = (LAS float*)(lds + 32768);
        for (int i = tid; i < 6 * 1024; i += 512) { const int s = i >> 10, k = i & 1023; const float c = s < 2 ? P.in[2][s * 1024 + k] : P.in[3][(s - 2) * 1024 + k]; sc[i] = c / (1.0f + __expf(-c)); }
        __syncthreads();
        for (int strip = bx; strip < 256; strip += G) {
            const int cgi = tid % 6, kk = tid / 6;
            if (kk < 85) {
                f32x4 a[6];
#pragma unroll
                for (int s = 0; s < 6; ++s) a[s] = (f32x4){0.f, 0.f, 0.f, 0.f};
                for (int k = kk; k < 1024; k += 85) { const f32x4 w = *(const f32x4*)(P.in[5] + (size_t)k * 6144 + strip * 24 + cgi * 4);
#pragma unroll
                    for (int s = 0; s < 6; ++s) a[s] += w * sc[s * 1024 + k]; }
#pragma unroll
                for (int s = 0; s < 6; ++s) *(LAS f32x4*)(part + ((kk * 6 + cgi) * 6 + s) * 4) = a[s];
            }
            __syncthreads();
            if (tid < 144) { const int cgi2 = tid / 24, s = (tid / 4) % 6, e = tid & 3; float acc = 0.f;
                for (int k2 = 0; k2 < 85; ++k2) acc += part[((k2 * 6 + cgi2) * 6 + s) * 4 + e];
                const int col = strip * 24 + cgi2 * 4 + e; mod[s * 6144 + col] = acc + P.in[6][col]; }
            __syncthreads();
        }
        { const int gt = bx * 512 + tid; if (gt < 4096) { const int pos = gt >> 4, i = gt & 15; const float inv = powf(10000.0f, -(float)i / 16.0f); const float ang = (float)pos * inv;
            float sn, cs; sincosf(ang, &sn, &cs); ((float*)(ws + WS_ROPE))[gt * 2] = cs; ((float*)(ws + WS_ROPE))[gt * 2 + 1] = sn; } }
        if (bx == 0 && wave == 0) { const float a = wave_sum(P.in[11][lane] * P.in[12][lane]), b = wave_sum(P.in[13][lane] * P.in[14][lane]);
            if (lane == 0) *(float*)(ws + WS_LAM) = expf(a) - expf(b) + 0.2f;
            float gq = fabsf(P.in[9][lane]), gk = fabsf(P.in[10][lane]);
#pragma unroll
            for (int o = 1; o < 64; o <<= 1) { gq = fmaxf(gq, __shfl_xor(gq, o)); gk = fmaxf(gk, __shfl_xor(gk, o)); }
            if (lane == 0) *(float*)(ws + WS_LAM + 4) = 64.0f * QSCALE * gq * gk * 1.02f + 0.1f; }
    }
    grid.sync();
    const XcdBarrier xbar = xcd_barrier_post((unsigned*)(ws + WS_BAR), bst);

    { IDS();
    for (int m0 = gw * 4; m0 < NTOK; m0 += NGW * 4) {
        const int s = seq_of_row(m0); const float* md = mod + s * 6144;
        f32x4 v[4][4]; float ss[4];
#pragma unroll
        for (int r = 0; r < 4; ++r) { const float* xr = x_row(P, m0 + r); ss[r] = 0.f;
#pragma unroll
            for (int j = 0; j < 4; ++j) v[r][j] = *(const f32x4*)(xr + 4 * lane + 256 * j); }
#pragma unroll
        for (int r = 0; r < 4; ++r)
#pragma unroll
            for (int j = 0; j < 4; ++j) ss[r] += (v[r][j].x * v[r][j].x + v[r][j].y * v[r][j].y) + (v[r][j].z * v[r][j].z + v[r][j].w * v[r][j].w);
        wave_sum4(ss);
#pragma unroll
        for (int r = 0; r < 4; ++r) ss[r] = __builtin_amdgcn_rsqf(ss[r] * (1.0f / DM) + EPS);
#pragma unroll
        for (int j = 0; j < 4; ++j) { const int c = 4 * lane + 256 * j; const f32x4 g = *(const f32x4*)(P.in[7] + c), sh = *(const f32x4*)(md + c), scl = *(const f32x4*)(md + 1024 + c);
            const f32x4 gg = g * (scl + 1.0f);
#pragma unroll
            for (int r = 0; r < 4; ++r) { const f32x4 y = v[r][j] * ss[r] * gg + sh; u32x2 w; w.x = pk2(y.x, y.y); w.y = pk2(y.z, y.w); *(u32x2*)((bf16*)(ws + WS_H) + (size_t)(m0 + r) * DM + c) = w; } }
    } }
    xcd_barrier(xbar);

    { pg8::Gemm g{(const bf16*)(ws + WS_H), (const bf16*)(ws + WS_WIN), NTOK, INW, DM}; pg8::StaticOrder S; S.init(NTOK, INW, G, bx);
      EpiProj E{(bf16*)(ws + WS_PROJ), INW, ws};
      pg8::gemm_phase<EpiProj, pg8::StaticOrder, true, true>(lds, g, S, E); }
    xcd_barrier(xbar);

    { IDS();
    for (int m0 = gw * 4; m0 < NTOK; m0 += NGW * 4) {
        const int s = seq_of_row(m0), sb = seq_base(s), n = seq_len(s);
        const bf16* pr = (const bf16*)(ws + WS_PROJ) + (size_t)m0 * INW;
        const int c8 = lane & 7, hh = lane >> 3, rk = lane >> 4, l4 = lane & 15;
        u32x4 wq[4];
#pragma unroll
        for (int r = 0; r < 4; ++r) wq[r] = *(const u32x4*)(pr + (size_t)r * INW + lane * 8);
        const u32x4 wk = *(const u32x4*)(pr + (size_t)rk * INW + 512 + l4 * 8);
#pragma unroll
        for (int r = 0; r < 4; ++r) { const int t = m0 + r - sb, tile = t >> 6, key = t & 63;
            float v[8] = {bflo(wq[r].x), bfhi(wq[r].x), bflo(wq[r].y), bfhi(wq[r].y), bflo(wq[r].z), bfhi(wq[r].z), bflo(wq[r].w), bfhi(wq[r].w)};
            norm_rope8(v, c8, P.in[9], ropetab, tile, key);
            *(u32x4*)(ws + WS_QG + ((size_t)sb * 8 + (size_t)hh * n + t) * 128 + c8 * 16) = pk8(v, QSCALE); }
        { const int t = m0 + rk - sb, tile = t >> 6, key = t & 63, kvh = l4 >> 3;
          float v[8] = {bflo(wk.x), bfhi(wk.x), bflo(wk.y), bfhi(wk.y), bflo(wk.z), bfhi(wk.z), bflo(wk.w), bfhi(wk.w)};
          norm_rope8(v, c8, P.in[10], ropetab, tile, key);
          *(u32x4*)(ws + WS_KG + ((size_t)sb * 2 + (size_t)kvh * n) * 128 + (size_t)tile * 8192 + k_img(key, c8 * 8)) = pk8(v, 1.0f); }
    }
    { unsigned* kq = (unsigned*)(ws + WS_BAR) + 3800;
      for (int g = gw; g < 2 * 6144; g += NGW) {
          const int isq = g >= 6144 ? 1 : 0, gt = isq ? g - 6144 : g;
          const int R = gt * 64, s = seq_of_row(R >> 3), sb = seq_base(s), n = seq_len(s), hh = (R - sb * 8) / n;
          const unsigned char* base = ws + (isq ? WS_QD : WS_KD) + (size_t)gt * 8192;
          float ss = 0.f;
#pragma unroll
          for (int i = 0; i < 8; ++i) { const u32x4 w = *(const u32x4*)(base + (isq ? lane * 128 + i * 16 : i * 1024 + lane * 16));
              const float f0 = bflo(w.x), f1 = bfhi(w.x), f2 = bflo(w.y), f3 = bfhi(w.y), f4 = bflo(w.z), f5 = bfhi(w.z), f6 = bflo(w.w), f7 = bfhi(w.w);
              ss += (f0 * f0 + f1 * f1) + (f2 * f2 + f3 * f3) + (f4 * f4 + f5 * f5) + (f6 * f6 + f7 * f7); }
#pragma unroll
          for (int o = 1; o < 64; o <<= 1) ss = fmaxf(ss, __shfl_xor(ss, o));
          if (lane == 0) atomicMax(kq + isq * 48 + s * 8 + hh, __float_as_uint(ss));
      } }
    }
    xcd_barrier(xbar);

    for (int L = vcu; L < 2304; L += G) {
        int diff, s, head, qb; attn_decode(L, diff, s, head, qb);
        const float sref = *(const float*)(ws + WS_LAM + 4);
        if (diff) {
            const unsigned* kq = (const unsigned*)(ws + WS_BAR) + 3800;
            float bmx = -3.0e38f, bmn = 3.0e38f;
            for (int b = 0; b < 32; ++b) { const float v = P.in[4][b * 4 + head] * LOG2E; bmx = fmaxf(bmx, v); bmn = fminf(bmn, v); }
            const int si = s * 8 + head * 2;
            const float qk0 = __builtin_sqrtf(__uint_as_float(kq[si]) * __uint_as_float(kq[48 + si])), qk1 = __builtin_sqrtf(__uint_as_float(kq[si + 1]) * __uint_as_float(kq[48 + si + 1]));
            if (2.0f * fmaxf(qk0, qk1) + (bmx - bmn) <= 100.0f) att2::attn_unit<4, true, true>((LAS char*)lds, P, s, head, qb, bmx);
            else att2::attn_unit<4, true, false>((LAS char*)lds, P, s, head, qb, 0.f);
        }
        else if (sref <= 40.0f) att2::attn_unit<2, false, true>((LAS char*)lds, P, s, head, qb, sref);
        else att2::attn_unit<2, false, false>((LAS char*)lds, P, s, head, qb, 0.f);
    }
    xcd_barrier(xbar);

    { pg8::Gemm g{(const bf16*)(ws + WS_MIX), (const bf16*)(ws + WS_WOUT), NTOK, DM, DM}; pg8::StaticOrder S; S.init(NTOK, DM, G, bx);
      pg8::EpiBf16 E{(bf16*)(ws + WS_O), DM};
      pg8::gemm_phase<pg8::EpiBf16, pg8::StaticOrder, true, true>(lds, g, S, E); }
    xcd_barrier(xbar);

    { IDS();
    for (int m0 = gw * 4; m0 < NTOK; m0 += NGW * 4) {
        const int s = seq_of_row(m0); const float* md = mod + s * 6144;
        f32x4 ov[4][4], xv[4][4]; float ss[4];
#pragma unroll
        for (int r = 0; r < 4; ++r) { const bf16* orow = (const bf16*)(ws + WS_O) + (size_t)(m0 + r) * DM; const float* xr = x_row(P, m0 + r); ss[r] = 0.f;
#pragma unroll
            for (int j = 0; j < 4; ++j) { const u32x2 w = *(const u32x2*)(orow + 4 * lane + 256 * j); ov[r][j] = (f32x4){bflo(w.x), bfhi(w.x), bflo(w.y), bfhi(w.y)}; xv[r][j] = *(const f32x4*)(xr + 4 * lane + 256 * j); } }
#pragma unroll
        for (int r = 0; r < 4; ++r)
#pragma unroll
            for (int j = 0; j < 4; ++j) ss[r] += (ov[r][j].x * ov[r][j].x + ov[r][j].y * ov[r][j].y) + (ov[r][j].z * ov[r][j].z + ov[r][j].w * ov[r][j].w);
        wave_sum4(ss);
        float s1[4];
#pragma unroll
        for (int r = 0; r < 4; ++r) { ss[r] = __builtin_amdgcn_rsqf(ss[r] * (1.0f / DM) + EPS); s1[r] = 0.f; }
#pragma unroll
        for (int j = 0; j < 4; ++j) { const int c = 4 * lane + 256 * j; const f32x4 g = *(const f32x4*)(P.in[17] + c), gt = *(const f32x4*)(md + 2048 + c); const f32x4 gg = g * gt;
#pragma unroll
            for (int r = 0; r < 4; ++r) { const f32x4 x1 = xv[r][j] + gg * (ov[r][j] * ss[r]); xv[r][j] = x1; s1[r] += (x1.x * x1.x + x1.y * x1.y) + (x1.z * x1.z + x1.w * x1.w);
                *(f32x4*)(P.out + (size_t)(m0 + r) * DM + c) = x1; } }
        wave_sum4(s1);
#pragma unroll
        for (int r = 0; r < 4; ++r) s1[r] = __builtin_amdgcn_rsqf(s1[r] * (1.0f / DM) + EPS);
#pragma unroll
        for (int j = 0; j < 4; ++j) { const int c = 4 * lane + 256 * j; const f32x4 g = *(const f32x4*)(P.in[18] + c), sh = *(const f32x4*)(md + 3072 + c), scl = *(const f32x4*)(md + 4096 + c); const f32x4 gg = g * (scl + 1.0f);
#pragma unroll
            for (int r = 0; r < 4; ++r) { const f32x4 y = xv[r][j] * s1[r] * gg + sh; u32x2 w; w.x = pk2(y.x, y.y); w.y = pk2(y.z, y.w); *(u32x2*)((bf16*)(ws + WS_H2) + (size_t)(m0 + r) * DM + c) = w; } }
    } }
    xcd_barrier(xbar);

    { pg8::Gemm g{(const bf16*)(ws + WS_H2), (const bf16*)(ws + WS_WGU), NTOK, 2 * DFF, DM}; pg8::StaticOrder S; S.init(NTOK, 2 * DFF, G, bx);
      pg8::EpiSwiGLU E{(bf16*)(ws + WS_ACT), DFF};
      pg8::gemm_phase<pg8::EpiSwiGLU, pg8::StaticOrder, true, true>(lds, g, S, E); }
    xcd_barrier(xbar);

    { pg8::Gemm g{(const bf16*)(ws + WS_ACT), (const bf16*)(ws + WS_WDN), NTOK, DM, DFF}; pg8::StaticOrder S; S.init(NTOK, DM, G, bx);
      pg8::EpiBf16 E{(bf16*)(ws + WS_F), DM};
      pg8::gemm_phase<pg8::EpiBf16, pg8::StaticOrder, true, true>(lds, g, S, E); }
    xcd_barrier(xbar);

    { IDS();
    for (int m0 = gw * 4; m0 < NTOK; m0 += NGW * 4) {
        const int s = seq_of_row(m0); const float* md = mod + s * 6144;
        f32x4 fv[4][4], xv[4][4]; float ss[4];
#pragma unroll
        for (int r = 0; r < 4; ++r) { const bf16* frow = (const bf16*)(ws + WS_F) + (size_t)(m0 + r) * DM; const float* xr = P.out + (size_t)(m0 + r) * DM; ss[r] = 0.f;
#pragma unroll
            for (int j = 0; j < 4; ++j) { const u32x2 w = *(const u32x2*)(frow + 4 * lane + 256 * j); fv[r][j] = (f32x4){bflo(w.x), bfhi(w.x), bflo(w.y), bfhi(w.y)}; xv[r][j] = *(const f32x4*)(xr + 4 * lane + 256 * j); } }
#pragma unroll
        for (int r = 0; r < 4; ++r)
#pragma unroll
            for (int j = 0; j < 4; ++j) ss[r] += (fv[r][j].x * fv[r][j].x + fv[r][j].y * fv[r][j].y) + (fv[r][j].z * fv[r][j].z + fv[r][j].w * fv[r][j].w);
        wave_sum4(ss);
#pragma unroll
        for (int r = 0; r < 4; ++r) ss[r] = __builtin_amdgcn_rsqf(ss[r] * (1.0f / DM) + EPS);
#pragma unroll
        for (int j = 0; j < 4; ++j) { const int c = 4 * lane + 256 * j; const f32x4 g = *(const f32x4*)(P.in[21] + c), gt = *(const f32x4*)(md + 5120 + c); const f32x4 gg = g * gt;
#pragma unroll
            for (int r = 0; r < 4; ++r) *(f32x4*)(P.out + (size_t)(m0 + r) * DM + c) = xv[r][j] + gg * (fv[r][j] * ss[r]); }
    } }
}

extern "C" void kernel_launch(void* const* d_in, const int* in_sizes, int n_in, void* d_out, int out_size, void* d_ws, size_t ws_size, hipStream_t stream) {
    static int grid_blocks = 0;
    if (grid_blocks == 0) {
        if (n_in != 22 || out_size != NTOK * DM || ws_size < WS_END) { fprintf(stderr, "kernel_launch: unexpected shapes (n_in %d out %d ws %zu)\n", n_in, out_size, ws_size); grid_blocks = -1; return; }
        int dev = 0, cus = 0, per_cu = 0;
        if (hipGetDevice(&dev) != hipSuccess || hipDeviceGetAttribute(&cus, hipDeviceAttributeMultiprocessorCount, dev) != hipSuccess) { grid_blocks = -1; return; }
        if (hipFuncSetAttribute((const void*)fwd_megakernel, hipFuncAttributeMaxDynamicSharedMemorySize, LDS_BYTES) != hipSuccess) { fprintf(stderr, "kernel_launch: hipFuncSetAttribute failed\n"); grid_blocks = -1; return; }
        if (hipOccupancyMaxActiveBlocksPerMultiprocessor(&per_cu, (const void*)fwd_megakernel, NWAVES * 64, LDS_BYTES) != hipSuccess || per_cu < 1) { fprintf(stderr, "kernel_launch: occupancy query failed (%d)\n", per_cu); per_cu = 1; }
        (void)hipGetLastError();
        grid_blocks = cus * per_cu;
    }
    if (grid_blocks < 0) return;
    Params p{};
    for (int i = 0; i < 22; ++i) p.in[i] = (const float*)d_in[i];
    p.out = (float*)d_out; p.ws = (unsigned char*)d_ws;
    void* args[] = {&p};
    hipError_t e = hipLaunchCooperativeKernel((const void*)fwd_megakernel, dim3(grid_blocks), dim3(NWAVES * 64), args, LDS_BYTES, stream);
    if (e != hipSuccess) fprintf(stderr, "cooperative launch failed: %s (grid %d)\n", hipGetErrorString(e), grid_blocks);
}
```
